# Optimizing an MI355X kernel written in HIP

```python
import math
import jax, jax.numpy as jnp
from jax import lax
import numpy as np

D_MODEL = 4096
BATCH = 2
SEQ = 8192
DEPTH = 1
DEC_BATCH = 8
DEC_SEQ = 64
PAST_LEN = 1024

CHUNK = 64
Q_BLOCK = 128
RET_HEADS = 8
RET_DK = 256
RET_DV = 256
MLA_HEADS = 16
NOPE_DIM = 128
ROPE_DIM = 64
V_DIM = 128
Q_LORA = 1024
KV_LORA = 512
MLA_SCALE = (NOPE_DIM + ROPE_DIM) ** -0.5
RET_QK = RET_HEADS * RET_DK
RET_VW = RET_HEADS * RET_DV
MLA_VW = MLA_HEADS * V_DIM
D_MIX = RET_VW + MLA_VW
IN_SIZES = (RET_QK, RET_QK, RET_VW, RET_VW, Q_LORA, KV_LORA, ROPE_DIM)
D_IN = 2 * RET_QK + 2 * RET_VW + Q_LORA + KV_LORA + ROPE_DIM
D_FF = 11008
ROPE_BASE = 10000.0
EPS = 1e-6

kernel_name = "hybrid_retention_mla_macaron_stream_step"

F32 = jnp.float32


def rms_norm(x, g):
    xf = x.astype(F32)
    y = xf * lax.rsqrt(jnp.mean(xf * xf, axis=-1, keepdims=True) + EPS)
    return (y * g.astype(F32)).astype(x.dtype)


def rope(x, pos):
    d = x.shape[-1]
    inv = ROPE_BASE ** (-jnp.arange(0, d, 2, dtype=F32) / d)
    ang = pos.astype(F32)[:, None] * inv[None, :]
    cos = jnp.cos(ang)[None, :, None, :]
    sin = jnp.sin(ang)[None, :, None, :]
    xf = x.astype(F32)
    x1, x2 = xf[..., : d // 2], xf[..., d // 2:]
    return jnp.concatenate([x1 * cos - x2 * sin, x2 * cos + x1 * sin], axis=-1).astype(x.dtype)


def swiglu(x, w_gate, w_up, w_down):
    return (jax.nn.silu(x @ w_gate) * (x @ w_up)) @ w_down


def retention_log_decay():
    return jnp.log1p(-jnp.exp2(-5.0 - jnp.arange(RET_HEADS, dtype=F32)))


def retention_chunk(S, q, k, v, log_g):
    L = q.shape[1]
    idx = jnp.arange(L, dtype=F32)
    diff = idx[:, None] - idx[None, :]
    dmask = jnp.where(diff[None] >= 0, jnp.exp(log_g[:, None, None] * diff[None]), 0.0)
    inner = jnp.einsum('blhd,bmhd->bhlm', q, k) * dmask[None]
    o = jnp.einsum('bhlm,bmhe->blhe', inner, v)
    q_dec = jnp.exp(log_g[None, :] * (idx[:, None] + 1.0))
    o = o + jnp.einsum('blhd,bhde->blhe', q * q_dec[None, :, :, None], S)
    k_dec = jnp.exp(log_g[None, :] * (L - 1.0 - idx)[:, None])
    S_new = jnp.exp(log_g * L)[None, :, None, None] * S + jnp.einsum(
        'blhd,blhe->bhde', k * k_dec[None, :, :, None], v)
    return S_new, o


def retention_prompt(q, k, v, log_g):
    B, S = q.shape[0], q.shape[1]
    n_c = S // CHUNK

    def to_chunks(t):
        return t.astype(F32).reshape(B, n_c, CHUNK, RET_HEADS, t.shape[-1]).transpose(1, 0, 2, 3, 4)

    S0 = jnp.zeros((B, RET_HEADS, RET_DK, RET_DV), F32)

    def step(Sc, qkv):
        qc, kc, vc = qkv
        return retention_chunk(Sc, qc, kc, vc, log_g)

    S_fin, o = lax.scan(step, S0, (to_chunks(q), to_chunks(k), to_chunks(v)))
    o = o.transpose(1, 0, 2, 3, 4).reshape(B, S, RET_HEADS, RET_DV)
    return o, S_fin


def retention_out(o, g_gate, gain):
    B, T = o.shape[0], o.shape[1]
    mu = jnp.mean(o, axis=-1, keepdims=True)
    var = jnp.mean(jnp.square(o - mu), axis=-1, keepdims=True)
    o = ((o - mu) * lax.rsqrt(var + EPS)).reshape(B, T, RET_VW) * gain.astype(F32)
    return (jax.nn.silu(g_gate.astype(F32)) * o).astype(g_gate.dtype)


def mla_scores(q_n, q_r, k_n, k_r):
    s = jnp.einsum('bqhd,bkhd->bhqk', q_n, k_n) + jnp.einsum('bqhd,bkd->bhqk', q_r, k_r)
    return s.astype(F32) * MLA_SCALE


def mla_attend_prompt(q_n, q_r, k_n, k_r, v):
    B, S = q_n.shape[0], q_n.shape[1]
    nb = S // Q_BLOCK
    qn_b = q_n.reshape(B, nb, Q_BLOCK, MLA_HEADS, NOPE_DIM).transpose(1, 0, 2, 3, 4)
    qr_b = q_r.reshape(B, nb, Q_BLOCK, MLA_HEADS, ROPE_DIM).transpose(1, 0, 2, 3, 4)
    key_chunk = jnp.arange(S) // CHUNK

    def block(args):
        qn, qr, i = args
        s = mla_scores(qn, qr, k_n, k_r)
        q_chunk = (i * Q_BLOCK + jnp.arange(Q_BLOCK)) // CHUNK
        mask = key_chunk[None, :] <= q_chunk[:, None]
        p = jax.nn.softmax(jnp.where(mask[None, None], s, -jnp.inf), axis=-1).astype(v.dtype)
        return jnp.einsum('bhqk,bkhd->bqhd', p, v)

    o = lax.map(block, (qn_b, qr_b, jnp.arange(nb)))
    return o.transpose(1, 0, 2, 3, 4).reshape(B, S, MLA_VW)


def mla_attend_full(q_n, q_r, k_n, k_r, v):
    B, T = q_n.shape[0], q_n.shape[1]
    p = jax.nn.softmax(mla_scores(q_n, q_r, k_n, k_r), axis=-1).astype(v.dtype)
    return jnp.einsum('bhqk,bkhd->bqhd', p, v).reshape(B, T, MLA_VW)


def mixer(z, pos, lw, ret_state=None, cache_c=None, cache_kr=None):
    B, T = z.shape[0], z.shape[1]
    offs = [int(v) for v in np.cumsum(IN_SIZES)[:-1]]
    rq, rk, rv, rg, q_lat, kv_lat, kr_raw = jnp.split(z, offs, axis=-1)
    q = rope(rq.reshape(B, T, RET_HEADS, RET_DK), pos)
    k = rope(rk.reshape(B, T, RET_HEADS, RET_DK), pos) * (RET_DK ** -0.5)
    v = rv.reshape(B, T, RET_HEADS, RET_DV)
    log_g = retention_log_decay()
    if ret_state is None:
        o_r, S_new = retention_prompt(q, k, v, log_g)
    else:
        S_new, o_r = retention_chunk(ret_state.astype(F32), q.astype(F32), k.astype(F32),
                                     v.astype(F32), log_g)
    ret_o = retention_out(o_r, rg, lw['g_ret'])
    qh = (rms_norm(q_lat, lw['g_qa']) @ lw['w_uq']).reshape(B, T, MLA_HEADS, NOPE_DIM + ROPE_DIM)
    q_n = rms_norm(qh[..., :NOPE_DIM], lw['g_qn'])
    q_r = rope(rms_norm(qh[..., NOPE_DIM:], lw['g_qr']), pos)
    c_new = rms_norm(kv_lat, lw['g_kva'])
    kr_new = rope(rms_norm(kr_raw, lw['g_kr'])[:, :, None, :], pos)[:, :, 0, :]
    if cache_c is None:
        c_all, kr_all = c_new, kr_new
    else:
        c_all = jnp.concatenate([cache_c.astype(c_new.dtype), c_new], axis=1)
        kr_all = jnp.concatenate([cache_kr.astype(kr_new.dtype), kr_new], axis=1)
    Tk = c_all.shape[1]
    kv = (c_all @ lw['w_ukv']).reshape(B, Tk, MLA_HEADS, NOPE_DIM + V_DIM)
    k_n = rms_norm(kv[..., :NOPE_DIM], lw['g_kn'])
    v_m = kv[..., NOPE_DIM:]
    if cache_c is None:
        mla_o = mla_attend_prompt(q_n, q_r, k_n, kr_all, v_m)
    else:
        mla_o = mla_attend_full(q_n, q_r, k_n, kr_all, v_m)
    o = jnp.concatenate([ret_o, mla_o.astype(ret_o.dtype)], axis=-1)
    return o, S_new, c_new, kr_new


def macaron_layer(x, mix, lw):
    h = x + 0.5 * swiglu(rms_norm(x, lw['g_ffn1']), lw['w1_gate'], lw['w1_up'], lw['w1_down'])
    o, s_ret, c_new, kr_new = mix(rms_norm(h, lw['g_mix']) @ lw['w_in'])
    h = h + o @ lw['w_out']
    h = h + 0.5 * swiglu(rms_norm(h, lw['g_ffn2']), lw['w2_gate'], lw['w2_up'], lw['w2_down'])
    return rms_norm(h, lw['g_final']), s_ret, c_new, kr_new


def setup_inputs(seed: int = 0) -> dict:
    key = jax.random.key(seed)
    ks = iter(jax.random.split(key, 40))

    def dense(shape, fan_in):
        return jax.random.normal(next(ks), shape, F32) * (fan_in ** -0.5)

    def gain(n):
        return 1.0 + 0.02 * jax.random.normal(next(ks), (DEPTH, n), F32)

    x_prompt = jax.random.normal(next(ks), (BATCH, SEQ, D_MODEL), F32)
    x_sample = jax.random.normal(next(ks), (DEC_BATCH, DEC_SEQ, D_MODEL), F32)
    state_ret = jax.random.normal(next(ks), (DEPTH, DEC_BATCH, RET_HEADS, RET_DK, RET_DV), F32)
    cache_ckv = jax.random.normal(next(ks), (DEPTH, DEC_BATCH, PAST_LEN, KV_LORA), F32)
    cache_krope = jax.random.normal(next(ks), (DEPTH, DEC_BATCH, PAST_LEN, ROPE_DIM), F32)
    return {
        'x_prompt': x_prompt, 'x_sample': x_sample,
        'state_ret': state_ret, 'cache_ckv': cache_ckv, 'cache_krope': cache_krope,
        'g_ffn1': gain(D_MODEL),
        'w1_gate': dense((DEPTH, D_MODEL, D_FF), D_MODEL),
        'w1_up': dense((DEPTH, D_MODEL, D_FF), D_MODEL),
        'w1_down': dense((DEPTH, D_FF, D_MODEL), D_FF),
        'g_mix': gain(D_MODEL),
        'w_in': dense((DEPTH, D_MODEL, D_IN), D_MODEL),
        'g_ret': gain(RET_VW),
        'g_qa': gain(Q_LORA),
        'w_uq': dense((DEPTH, Q_LORA, MLA_HEADS * (NOPE_DIM + ROPE_DIM)), Q_LORA),
        'g_qn': gain(NOPE_DIM),
        'g_qr': gain(ROPE_DIM),
        'g_kva': gain(KV_LORA),
        'g_kr': gain(ROPE_DIM),
        'w_ukv': dense((DEPTH, KV_LORA, MLA_HEADS * (NOPE_DIM + V_DIM)), KV_LORA),
        'g_kn': gain(NOPE_DIM),
        'w_out': dense((DEPTH, D_MIX, D_MODEL), D_MIX),
        'g_ffn2': gain(D_MODEL),
        'w2_gate': dense((DEPTH, D_MODEL, D_FF), D_MODEL),
        'w2_up': dense((DEPTH, D_MODEL, D_FF), D_MODEL),
        'w2_down': dense((DEPTH, D_FF, D_MODEL), D_FF),
        'g_final': gain(D_MODEL),
    }


def reference(x_prompt, x_sample, state_ret, cache_ckv, cache_krope,
              g_ffn1, w1_gate, w1_up, w1_down, g_mix, w_in, g_ret,
              g_qa, w_uq, g_qn, g_qr, g_kva, g_kr, w_ukv, g_kn, w_out,
              g_ffn2, w2_gate, w2_up, w2_down, g_final):
    pos_p = jnp.arange(x_prompt.shape[1])
    pos_s = PAST_LEN + jnp.arange(x_sample.shape[1])
    xp, xs = x_prompt, x_sample
    sp_list, cp_list, kp_list, ss_list, cs_list, ksl = [], [], [], [], [], []
    for l in range(DEPTH):
        lw = dict(g_ffn1=g_ffn1[l], w1_gate=w1_gate[l], w1_up=w1_up[l], w1_down=w1_down[l],
                  g_mix=g_mix[l], w_in=w_in[l], g_ret=g_ret[l], g_qa=g_qa[l], w_uq=w_uq[l],
                  g_qn=g_qn[l], g_qr=g_qr[l], g_kva=g_kva[l], g_kr=g_kr[l], w_ukv=w_ukv[l],
                  g_kn=g_kn[l], w_out=w_out[l], g_ffn2=g_ffn2[l], w2_gate=w2_gate[l],
                  w2_up=w2_up[l], w2_down=w2_down[l], g_final=g_final[l])
        xp, s_p, c_p, k_p = macaron_layer(xp, lambda z: mixer(z, pos_p, lw), lw)
        xs, s_s, c_s, k_s = macaron_layer(
            xs, lambda z: mixer(z, pos_s, lw, state_ret[l], cache_ckv[l], cache_krope[l]), lw)
        sp_list.append(s_p); cp_list.append(c_p); kp_list.append(k_p)
        ss_list.append(s_s); cs_list.append(c_s); ksl.append(k_s)
    state_ret_prompt = jnp.stack(sp_list)
    cache_ckv_prompt = jnp.stack(cp_list)
    cache_krope_prompt = jnp.stack(kp_list)
    state_ret_sample = jnp.stack(ss_list)
    cache_ckv_sample = jnp.stack(cs_list)
    cache_krope_sample = jnp.stack(ksl)
    return (xp, xs, state_ret_prompt, cache_ckv_prompt, cache_krope_prompt,
            state_ret_sample, cache_ckv_sample, cache_krope_sample)
```

```cpp
#include <hip/hip_runtime.h>
#include <cstdio>
#include <cstdint>
namespace pg8 {
#define PG8_LAS __attribute__((address_space(3)))
typedef unsigned short bf16_t;
typedef short bf16x8 __attribute__((ext_vector_type(8)));
typedef float f32x4 __attribute__((ext_vector_type(4)));
typedef unsigned u32x4 __attribute__((ext_vector_type(4)));
constexpr int BM = 256, BK = 64, HALF = 128, HTB = HALF * BK * 2  , STAGE_BYTES = 8 * HTB, NXCD = 8, WGM = 8;

__host__ __device__ __forceinline__ int lds_byte(int r, int c) { const int st = (r >> 4) * 2 + (c >> 5), rr = r & 15, cc = c & 31, ob = rr * 64 + cc * 2; return st * 1024 + (ob ^ (((ob >> 9) & 1) << 5)); }
__host__ __device__ __forceinline__ void stage_rc(int b, int& R, int& C) { const int st = b / 1024, sb = b % 1024, swz = sb ^ (((sb >> 9) & 1) << 5); R = (st >> 1) * 16 + swz / 64; C = (st & 1) * 32 + (swz % 64) / 2; }
__host__ __device__ __forceinline__ int perm32(int rho) { const int n = rho >> 4, i = rho & 15; return 8 * (i >> 2) + 4 * n + (i & 3); }

struct Unit { int pm, pn, kt0, nt; };
struct Gemm { const bf16_t* A; const bf16_t* Bt; int M, N, K; };

struct StaticOrder {
    int nM, nN, nwg, G, c, ntk, wgm;
    __host__ __device__ __forceinline__ void init(int M, int N, int G_, int c_, int K) { nM = M / BM; nN = N / BM; nwg = nM * nN; G = G_; c = c_; ntk = K / BK; wgm = WGM; }
    __host__ __device__ __forceinline__ void tile(int L, Unit& u) const {
        int wgid = L; { const int q = nwg / NXCD, r = nwg % NXCD, xcd = wgid % NXCD, off = wgid / NXCD; wgid = (xcd < r ? xcd * (q + 1) : r * (q + 1) + (xcd - r) * q) + off; }
        const int nig = wgm * nN, gid = wgid / nig, fm = gid * wgm, gsz = (nM - fm) < wgm ? (nM - fm) : wgm;
        u.pm = fm + ((wgid % nig) % gsz); u.pn = (wgid % nig) / gsz;
    }
    __host__ __device__ __forceinline__ bool next(int i, Unit& u) const {
        const long L = (long)i * G + c; if (L >= nwg) return false;
        tile((int)L, u); u.kt0 = 0; u.nt = ntk; return true;
    }
    __device__ __forceinline__ void a_ready(const Unit&) const {}
    __device__ __forceinline__ void done(const Unit&) const {}
};
struct SplitTailOrder : StaticOrder {
    __host__ __device__ __forceinline__ bool next(int i, Unit& u) const {
        const int R = nwg / G, rem = nwg - R * G;
        if (i < R) { tile(i * G + c, u); u.kt0 = 0; u.nt = ntk; return true; }
        if (i > R || rem == 0) return false;
        const int S = G / rem, t = c / S, p = c - t * S; if (t >= rem) return false;
        tile(R * G + t, u);
        const int pairs = ntk / 2, q = pairs / S, r = pairs - q * S;
        u.kt0 = 2 * (p * q + (p < r ? p : r)); u.nt = 2 * (q + (p < r ? 1 : 0)); return true;
    }
};
struct WinOrder : StaticOrder {
    int r0, r1;
    __host__ __device__ __forceinline__ bool next(int i, Unit& u) const {
        const int r = i + r0; const long L = (long)r * G + c; if (r >= r1 || L >= nwg) return false;
        tile((int)L, u); u.pn += 10; if (u.pn >= nN) u.pn -= nN; u.kt0 = 0; u.nt = ntk; return true;
    }
};
typedef float f32x2_t __attribute__((ext_vector_type(2))); typedef __bf16 bf16x2_t __attribute__((ext_vector_type(2)));
__device__ __forceinline__ unsigned cvt_pk_bf16(float lo, float hi) { f32x2_t v = {lo, hi}; bf16x2_t b = __builtin_convertvector(v, bf16x2_t); return __builtin_bit_cast(unsigned, b); }
typedef float f32x2 __attribute__((ext_vector_type(2)));
__device__ __forceinline__ float fast_silu(float g) { return g * __builtin_amdgcn_rcpf(1.0f + __builtin_amdgcn_exp2f(-1.4426950408889634f * g)); }
struct EpiSwiGLU {
    static constexpr bool PERM = true, AFTER_DRAIN = false;
    bf16_t* H; int ldh;
    __device__ __forceinline__ void operator()(const f32x4 (&acc)[2][2][4][2], const Unit& u, int wr, int wc, int fr, int fq) const {
        const int row0 = u.pm * BM + wr * 64 + fr, col0 = u.pn * HALF + wc * 32 + 8 * fq;
#pragma unroll
        for (int ai = 0; ai < 2; ++ai)
#pragma unroll
            for (int m = 0; m < 4; ++m) { bf16_t* rowp = H + (size_t)(row0 + ai * HALF + m * 16) * ldh + col0;
                const f32x4 g0 = acc[ai][0][m][0], g1 = acc[ai][0][m][1], u0 = acc[ai][1][m][0], u1 = acc[ai][1][m][1];
                f32x4 v0, v1;
#pragma unroll
                for (int j = 0; j < 4; ++j) { v0[j] = fast_silu(g0[j]) * u0[j]; v1[j] = fast_silu(g1[j]) * u1[j]; }
                u32x4 w; w.x = cvt_pk_bf16(v0[0], v0[1]); w.y = cvt_pk_bf16(v0[2], v0[3]); w.z = cvt_pk_bf16(v1[0], v1[1]); w.w = cvt_pk_bf16(v1[2], v1[3]);
                *(u32x4*)rowp = w; }
    }
};
template <bool BASE_BF16> struct EpiResid {
    static constexpr bool PERM = true, AFTER_DRAIN = false;
    const float* base0; const float* base1; int split_pm; bf16_t* hout; int ldc; float alpha; int ntk_full; float* slabs;
    __device__ __forceinline__ void operator()(const f32x4 (&acc)[2][2][4][2], const Unit& u, int wr, int wc, int fr, int fq) const {
        const int row0 = u.pm * BM + wr * 64 + fr, col0 = u.pn * BM + wc * 32 + 8 * fq;
        if (u.nt != ntk_full) {
            bf16_t* sp = (bf16_t*)slabs + (size_t)blockIdx.x * 65536 + (size_t)(wr * 64 + fr) * 256 + wc * 32 + 8 * fq;
#pragma unroll
            for (int ai = 0; ai < 2; ++ai)
#pragma unroll
                for (int m = 0; m < 4; ++m) {
#pragma unroll
                    for (int bj = 0; bj < 2; ++bj) { const f32x4 a0 = acc[ai][bj][m][0], a1 = acc[ai][bj][m][1];
                        u32x4 w; w.x = cvt_pk_bf16(a0[0], a0[1]); w.y = cvt_pk_bf16(a0[2], a0[3]); w.z = cvt_pk_bf16(a1[0], a1[1]); w.w = cvt_pk_bf16(a1[2], a1[3]); *(u32x4*)(sp + bj * HALF) = w; }
                    sp += (m == 3 ? (HALF - 48) : 16) * 256; asm volatile("" : "+v"(sp)); }
            return;
        }
        const float* bb = (u.pm >= split_pm) ? base1 - (size_t)split_pm * BM * ldc : base0;
        if constexpr (BASE_BF16) {
            u32x4 bw[2][4][2];
#pragma unroll
            for (int ai = 0; ai < 2; ++ai)
#pragma unroll
                for (int m = 0; m < 4; ++m) { const size_t off = (size_t)(row0 + ai * HALF + m * 16) * ldc + col0;
#pragma unroll
                    for (int bj = 0; bj < 2; ++bj) bw[ai][m][bj] = *(const u32x4*)(hout + off + bj * HALF); }
#pragma unroll
            for (int ai = 0; ai < 2; ++ai)
#pragma unroll
                for (int m = 0; m < 4; ++m) { const size_t off = (size_t)(row0 + ai * HALF + m * 16) * ldc + col0;
#pragma unroll
                    for (int bj = 0; bj < 2; ++bj) { const u32x4 b4 = bw[ai][m][bj];
                        const f32x4 b0 = (f32x4){__builtin_bit_cast(float, b4.x << 16), __builtin_bit_cast(float, b4.x & 0xffff0000u), __builtin_bit_cast(float, b4.y << 16), __builtin_bit_cast(float, b4.y & 0xffff0000u)};
                        const f32x4 b1 = (f32x4){__builtin_bit_cast(float, b4.z << 16), __builtin_bit_cast(float, b4.z & 0xffff0000u), __builtin_bit_cast(float, b4.w << 16), __builtin_bit_cast(float, b4.w & 0xffff0000u)};
                        const f32x4 h0 = b0 + alpha * acc[ai][bj][m][0], h1 = b1 + alpha * acc[ai][bj][m][1];
                        u32x4 w; w.x = cvt_pk_bf16(h0[0], h0[1]); w.y = cvt_pk_bf16(h0[2], h0[3]); w.z = cvt_pk_bf16(h1[0], h1[1]); w.w = cvt_pk_bf16(h1[2], h1[3]); *(u32x4*)(hout + off + bj * HALF) = w; } }
        } else {
#pragma unroll
            for (int ai = 0; ai < 2; ++ai) {
                f32x4 bv[4][2][2];
#pragma unroll
                for (int m = 0; m < 4; ++m) { const size_t off = (size_t)(row0 + ai * HALF + m * 16) * ldc + col0;
#pragma unroll
                    for (int bj = 0; bj < 2; ++bj)
#pragma unroll
                        for (int n = 0; n < 2; ++n) bv[m][bj][n] = *(const f32x4*)(bb + off + bj * HALF + n * 4); }
#pragma unroll
                for (int m = 0; m < 4; ++m) { const size_t off = (size_t)(row0 + ai * HALF + m * 16) * ldc + col0;
#pragma unroll
                    for (int bj = 0; bj < 2; ++bj) { const f32x4 h0 = bv[m][bj][0] + alpha * acc[ai][bj][m][0], h1 = bv[m][bj][1] + alpha * acc[ai][bj][m][1];
                        u32x4 w; w.x = cvt_pk_bf16(h0[0], h0[1]); w.y = cvt_pk_bf16(h0[2], h0[3]); w.z = cvt_pk_bf16(h1[0], h1[1]); w.w = cvt_pk_bf16(h1[2], h1[3]); *(u32x4*)(hout + off + bj * HALF) = w; } }
                asm volatile("" ::: "memory"); }
        }
    }
};
struct EpiZ {
    static constexpr bool PERM = true, AFTER_DRAIN = false;
    bf16_t* Z; int ldz; const float* rcos; const float* rsin;
    __device__ __forceinline__ void operator()(const f32x4 (&acc)[2][2][4][2], const Unit& u, int wr, int wc, int fr, int fq) const {
        const int row0 = u.pm * BM + wr * 64 + fr, col0 = u.pn * BM + wc * 32 + 8 * fq;
        const bool rope = u.pn < 16; const float sc = (u.pn >= 8 && u.pn < 16) ? 0.0625f : 1.0f;
#pragma unroll
        for (int ai = 0; ai < 2; ++ai)
#pragma unroll
            for (int m = 0; m < 4; ++m) { const int r = row0 + ai * HALF + m * 16; bf16_t* rowp = Z + (size_t)r * ldz + col0;
                f32x4 a0 = acc[ai][0][m][0], a1 = acc[ai][0][m][1], b0 = acc[ai][1][m][0], b1 = acc[ai][1][m][1];
                if (rope) { const int pos = r < 16384 ? (r & 8191) : 1024 + ((r - 16384) & 63);
                    const float* cp = rcos + (size_t)pos * 128 + wc * 32 + 8 * fq; const float* sp = rsin + (size_t)pos * 128 + wc * 32 + 8 * fq;
                    const f32x4 c0 = *(const f32x4*)cp, c1 = *(const f32x4*)(cp + 4), s0 = *(const f32x4*)sp, s1 = *(const f32x4*)(sp + 4);
                    const f32x4 x0 = a0, x1 = a1, y0 = b0, y1 = b1;
                    a0 = (x0 * c0 - y0 * s0) * sc; a1 = (x1 * c1 - y1 * s1) * sc; b0 = (y0 * c0 + x0 * s0) * sc; b1 = (y1 * c1 + x1 * s1) * sc; }
                u32x4 w; w.x = cvt_pk_bf16(a0[0], a0[1]); w.y = cvt_pk_bf16(a0[2], a0[3]); w.z = cvt_pk_bf16(a1[0], a1[1]); w.w = cvt_pk_bf16(a1[2], a1[3]);
                *(u32x4*)rowp = w;
                w.x = cvt_pk_bf16(b0[0], b0[1]); w.y = cvt_pk_bf16(b0[2], b0[3]); w.z = cvt_pk_bf16(b1[0], b1[1]); w.w = cvt_pk_bf16(b1[2], b1[3]);
                *(u32x4*)(rowp + HALF) = w; }
    }
};
struct EpiBf16P {
    static constexpr bool PERM = true, AFTER_DRAIN = false;
    bf16_t* O; int ldc;
    __device__ __forceinline__ void operator()(const f32x4 (&acc)[2][2][4][2], const Unit& u, int wr, int wc, int fr, int fq) const {
        const int row0 = u.pm * BM + wr * 64 + fr, col0 = u.pn * BM + wc * 32 + 8 * fq;
#pragma unroll
        for (int ai = 0; ai < 2; ++ai)
#pragma unroll
            for (int m = 0; m < 4; ++m) { bf16_t* rowp = O + (size_t)(row0 + ai * HALF + m * 16) * ldc + col0;
#pragma unroll
                for (int bj = 0; bj < 2; ++bj) { const f32x4 v0 = acc[ai][bj][m][0], v1 = acc[ai][bj][m][1];
                    u32x4 w; w.x = cvt_pk_bf16(v0[0], v0[1]); w.y = cvt_pk_bf16(v0[2], v0[3]); w.z = cvt_pk_bf16(v1[0], v1[1]); w.w = cvt_pk_bf16(v1[2], v1[3]);
                    *(u32x4*)(rowp + bj * HALF) = w; } }
    }
};
struct EpiKNorm {
    static constexpr bool PERM = true, AFTER_DRAIN = false;
    bf16_t* O; int ldc; const float* gk; PG8_LAS float* tab;
    __device__ __forceinline__ void operator()(const f32x4 (&acc)[2][2][4][2], const Unit& u, int wr, int wc, int fr, int fq) const {
        const int row0 = u.pm * BM + wr * 64 + fr, col0 = u.pn * BM + wc * 32 + 8 * fq;
#pragma unroll
        for (int ai = 0; ai < 2; ++ai)
#pragma unroll
            for (int m = 0; m < 4; ++m)
#pragma unroll
                for (int bj = 0; bj < 2; ++bj) { const f32x4 v0 = acc[ai][bj][m][0], v1 = acc[ai][bj][m][1];
                    float ss = (v0[0] * v0[0] + v0[1] * v0[1]) + (v0[2] * v0[2] + v0[3] * v0[3]) + (v1[0] * v1[0] + v1[1] * v1[1]) + (v1[2] * v1[2] + v1[3] * v1[3]);
                    ss += __shfl_xor(ss, 16); ss += __shfl_xor(ss, 32);
                    if (fq == 0) tab[((ai * HALF + wr * 64 + m * 16 + fr) * 2 + bj) * 4 + wc] = ss; }
        asm volatile("s_waitcnt lgkmcnt(0)" ::: "memory"); __builtin_amdgcn_s_barrier(); asm volatile("" ::: "memory");
        const f32x4 g0 = *(const f32x4*)(gk + wc * 32 + 8 * fq), g1 = *(const f32x4*)(gk + wc * 32 + 8 * fq + 4);
#pragma unroll
        for (int ai = 0; ai < 2; ++ai)
#pragma unroll
            for (int m = 0; m < 4; ++m) { bf16_t* rowp = O + (size_t)(row0 + ai * HALF + m * 16) * ldc + col0;
#pragma unroll
                for (int bj = 0; bj < 2; ++bj) { const f32x4 pr = *(const PG8_LAS f32x4*)(tab + ((ai * HALF + wr * 64 + m * 16 + fr) * 2 + bj) * 4);
                    const float rs = __builtin_amdgcn_rsqf(((pr[0] + pr[1]) + (pr[2] + pr[3])) * (1.0f / 128.0f) + 1e-6f);
                    const f32x4 v0 = acc[ai][bj][m][0] * rs * g0, v1 = acc[ai][bj][m][1] * rs * g1;
                    u32x4 w; w.x = cvt_pk_bf16(v0[0], v0[1]); w.y = cvt_pk_bf16(v0[2], v0[3]); w.z = cvt_pk_bf16(v1[0], v1[1]); w.w = cvt_pk_bf16(v1[2], v1[3]);
                    *(u32x4*)(rowp + bj * HALF) = w; } }
    }
};
template <class Epi, class Sched, bool ALIGN_EPI = false, bool SP2 = false>
__device__ __forceinline__ void gemm_phase(PG8_LAS unsigned char* lds, const Gemm g, const Sched& S, const Epi& E) {
    const int tid = threadIdx.x, wid = __builtin_amdgcn_readfirstlane(tid >> 6), lane = tid & 63, wr = wid >> 2, wc = wid & 3, fr = lane & 15, fq = lane >> 4;
    const int K = g.K;
    unsigned voffA[2], voffB[2];
#pragma unroll
    for (int i = 0; i < 2; ++i) { int R, C; stage_rc(tid * 16 + i * 8192, R, C); const int Rb = Epi::PERM ? ((R & ~31) + perm32(R & 31)) : R;
        voffA[i] = (unsigned)(R * K + C) * 2u; voffB[i] = (unsigned)(Rb * K + C) * 2u; }
    const size_t kstep = (size_t)(BK * 2);
    const size_t hstep = (size_t)HALF * K * 2;
    const size_t tstep = 2 * hstep;
    const unsigned ldsw = (unsigned)wid * 1024u;
    const int aoff = lds_byte(wr * 64 + fr, fq * 8), boff = lds_byte(wc * 32 + fr, fq * 8);
#define PG8_SA(b, h) (((b) * 2 + (h)) * HTB)
#define PG8_SB(b, h) ((4 + (b) * 2 + (h)) * HTB)
#define PG8_STAGE(bufoff, gbase, voff) do { _Pragma("unroll") for (int _i = 0; _i < 2; ++_i) \
        __builtin_amdgcn_global_load_lds((const unsigned*)((const char*)(gbase) + (voff)[_i]), (PG8_LAS unsigned*)(lds + (bufoff) + ldsw + _i * 8192), 16, 0, 0); } while (0)
#define PG8_LDA(dst, b, h) do { _Pragma("unroll") for (int m = 0; m < 4; ++m) _Pragma("unroll") for (int k = 0; k < 2; ++k) dst[m][k] = *(const PG8_LAS bf16x8*)(lds + PG8_SA(b, h) + aoff + m * 2048 + k * 1024); } while (0)
#define PG8_LDB(dst, b, h) do { _Pragma("unroll") for (int n = 0; n < 2; ++n) _Pragma("unroll") for (int k = 0; k < 2; ++k) dst[n][k] = *(const PG8_LAS bf16x8*)(lds + PG8_SB(b, h) + boff + n * 2048 + k * 1024); } while (0)
#define PG8_MMA(ai, bj, At, Bt) do { __builtin_amdgcn_s_setprio(1); _Pragma("unroll") for (int m = 0; m < 4; ++m) _Pragma("unroll") for (int n = 0; n < 2; ++n) _Pragma("unroll") for (int k = 0; k < 2; ++k) \
        acc[ai][bj][m][n] = __builtin_amdgcn_mfma_f32_16x16x32_bf16(Bt[n][k], At[m][k], acc[ai][bj][m][n], 0, 0, 0); __builtin_amdgcn_s_setprio(0); } while (0)
#define PG8_WAIT_V(n) asm volatile("s_waitcnt vmcnt(" #n ")" ::: "memory")
#define PG8_WAIT_L(n) asm volatile("s_waitcnt lgkmcnt(" #n ")" ::: "memory")
#define PG8_BAR __builtin_amdgcn_s_barrier()
#define PG8_SCHED __builtin_amdgcn_sched_barrier(0)
    Unit cur, nxt; int ui = 0;
    if (!S.next(0, cur)) return;
    f32x4 acc[2][2][4][2];
#pragma unroll
    for (int a = 0; a < 2; ++a)
#pragma unroll
        for (int b = 0; b < 2; ++b)
#pragma unroll
            for (int m = 0; m < 4; ++m)
#pragma unroll
                for (int n = 0; n < 2; ++n) acc[a][b][m][n] = (f32x4){0.f, 0.f, 0.f, 0.f};
    bf16x8 At[4][2], B0[2][2], B1[2][2];
    const char* cA = (const char*)g.A + (size_t)cur.pm * tstep + (size_t)cur.kt0 * kstep; const char* cB = (const char*)g.Bt + (size_t)cur.pn * tstep + (size_t)cur.kt0 * kstep;
    S.a_ready(cur);
    if constexpr (SP2) {
        PG8_STAGE(PG8_SB(0, 0), cB, voffB); PG8_STAGE(PG8_SB(0, 1), cB + hstep, voffB); PG8_STAGE(PG8_SA(0, 0), cA, voffA); PG8_STAGE(PG8_SA(0, 1), cA + hstep, voffA);
        if (wr == 1) PG8_BAR;
        PG8_WAIT_V(2); PG8_BAR;
        PG8_STAGE(PG8_SB(1, 0), cB + kstep, voffB); PG8_STAGE(PG8_SA(1, 0), cA + kstep, voffA); PG8_STAGE(PG8_SB(1, 1), cB + hstep + kstep, voffB);
        PG8_WAIT_V(6); PG8_BAR;
    } else {
        PG8_STAGE(PG8_SB(0, 0), cB, voffB); PG8_STAGE(PG8_SA(0, 0), cA, voffA); PG8_STAGE(PG8_SB(0, 1), cB + hstep, voffB); PG8_STAGE(PG8_SA(0, 1), cA + hstep, voffA);
        if (wr == 1) PG8_BAR;
        PG8_WAIT_V(4); PG8_BAR;
        PG8_STAGE(PG8_SB(1, 0), cB + kstep, voffB); PG8_STAGE(PG8_SA(1, 0), cA + kstep, voffA); PG8_STAGE(PG8_SB(1, 1), cB + hstep + kstep, voffB);
        PG8_WAIT_V(6); PG8_BAR;
    }
    for (;;) {
        const bool has_next = S.next(ui + 1, nxt);
        const char* nA = has_next ? (const char*)g.A + (size_t)nxt.pm * tstep + (size_t)nxt.kt0 * kstep : cA; const char* nB = has_next ? (const char*)g.Bt + (size_t)nxt.pn * tstep + (size_t)nxt.kt0 * kstep : cB;
        const int nt = cur.nt;
        for (int t = 0; t < nt; t += 2) {
            const bool last = (t == nt - 2);
            const char* a1 = cA + (size_t)(t + 1) * kstep;
            const char* a2 = last ? nA : cA + (size_t)(t + 2) * kstep; const char* b2 = last ? nB : cB + (size_t)(t + 2) * kstep;
            const char* a3 = a2 + kstep; const char* b3 = b2 + kstep;
            if (last && has_next) S.a_ready(nxt);
            if constexpr (SP2) {
            PG8_LDB(B0, 0, 0); PG8_LDB(B1, 0, 1); PG8_SCHED; PG8_LDA(At, 0, 0); PG8_STAGE(PG8_SA(1, 1), a1 + hstep, voffA);
            PG8_WAIT_V(8); PG8_WAIT_L(0); PG8_BAR; PG8_MMA(0, 0, At, B0); PG8_MMA(0, 1, At, B1); PG8_BAR; PG8_SCHED;
            PG8_LDA(At, 0, 1); PG8_STAGE(PG8_SB(0, 0), b2, voffB); PG8_STAGE(PG8_SB(0, 1), b2 + hstep, voffB); PG8_STAGE(PG8_SA(0, 0), a2, voffA);
            PG8_WAIT_V(8); PG8_WAIT_L(0); PG8_BAR; PG8_MMA(1, 0, At, B0); PG8_MMA(1, 1, At, B1); PG8_BAR; PG8_SCHED;
            PG8_LDB(B0, 1, 0); PG8_LDB(B1, 1, 1); PG8_SCHED; PG8_LDA(At, 1, 0); PG8_STAGE(PG8_SA(0, 1), a2 + hstep, voffA);
            PG8_WAIT_V(8); PG8_WAIT_L(0); PG8_BAR; PG8_MMA(0, 0, At, B0); PG8_MMA(0, 1, At, B1); PG8_BAR; PG8_SCHED;
            PG8_LDA(At, 1, 1); PG8_STAGE(PG8_SB(1, 0), b3, voffB); PG8_STAGE(PG8_SB(1, 1), b3 + hstep, voffB); PG8_STAGE(PG8_SA(1, 0), a3, voffA);
            PG8_WAIT_V(8); PG8_WAIT_L(0); PG8_BAR; PG8_MMA(1, 0, At, B0); PG8_MMA(1, 1, At, B1); PG8_BAR; PG8_SCHED;
            } else {
            PG8_LDB(B0, 0, 0); PG8_SCHED; PG8_LDA(At, 0, 0); PG8_STAGE(PG8_SA(1, 1), a1 + hstep, voffA);
            PG8_WAIT_L(8); PG8_BAR; PG8_WAIT_L(0); PG8_MMA(0, 0, At, B0); PG8_BAR; PG8_SCHED;
            PG8_LDB(B1, 0, 1); PG8_STAGE(PG8_SB(0, 0), b2, voffB);
            PG8_BAR; PG8_WAIT_L(0); PG8_MMA(0, 1, At, B1); PG8_BAR;
            PG8_LDA(At, 0, 1); PG8_STAGE(PG8_SA(0, 0), a2, voffA);
            PG8_BAR; PG8_WAIT_L(0); PG8_MMA(1, 0, At, B0); PG8_BAR; PG8_SCHED;
            PG8_STAGE(PG8_SB(0, 1), b2 + hstep, voffB);
            PG8_WAIT_V(6); PG8_BAR; PG8_MMA(1, 1, At, B1); PG8_BAR;
            PG8_LDB(B0, 1, 0); PG8_SCHED; PG8_LDA(At, 1, 0); PG8_STAGE(PG8_SA(0, 1), a2 + hstep, voffA);
            PG8_WAIT_L(8); PG8_BAR; PG8_WAIT_L(0); PG8_MMA(0, 0, At, B0); PG8_BAR; PG8_SCHED;
            PG8_LDB(B1, 1, 1); PG8_STAGE(PG8_SB(1, 0), b3, voffB);
            PG8_BAR; PG8_WAIT_L(0); PG8_MMA(0, 1, At, B1); PG8_BAR;
            PG8_LDA(At, 1, 1); PG8_STAGE(PG8_SA(1, 0), a3, voffA);
            PG8_BAR; PG8_WAIT_L(0); PG8_MMA(1, 0, At, B0); PG8_BAR; PG8_SCHED;
            PG8_STAGE(PG8_SB(1, 1), b3 + hstep, voffB);
            PG8_WAIT_V(6); PG8_BAR; PG8_MMA(1, 1, At, B1); PG8_BAR;
            }
        }
        if constexpr (ALIGN_EPI) { if (wr == 0) PG8_BAR; }
        if constexpr (!Epi::AFTER_DRAIN) { E(acc, cur, wr, wc, fr, fq); S.done(cur); }
        if (!has_next) break;
#pragma unroll
        for (int a = 0; a < 2; ++a)
#pragma unroll
            for (int b = 0; b < 2; ++b)
#pragma unroll
                for (int m = 0; m < 4; ++m)
#pragma unroll
                    for (int n = 0; n < 2; ++n) acc[a][b][m][n] = (f32x4){0.f, 0.f, 0.f, 0.f};
        cur = nxt; cA = nA; cB = nB; ++ui;
        if constexpr (ALIGN_EPI) { if (wr == 1) PG8_BAR; }
    }
    PG8_WAIT_V(0);
    if constexpr (!ALIGN_EPI) { if (wr == 0) PG8_BAR; }
    PG8_BAR;
    if constexpr (Epi::AFTER_DRAIN) { E.fused(acc, cur, wr, wc, fr, fq, lds, wid, lane); S.done(cur); }
#undef PG8_SA
#undef PG8_SB
#undef PG8_STAGE
#undef PG8_LDA
#undef PG8_LDB
#undef PG8_MMA
#undef PG8_WAIT_V
#undef PG8_WAIT_L
#undef PG8_BAR
#undef PG8_SCHED
}
}

constexpr int DM = 4096, TP = 16384, TS = 512, TT = TP + TS, SEQ = 8192, DFF = 11008, DIN = 9792, ZLD = 9984;
constexpr int KROWS = 25088;
constexpr int QLD = 3072, KNLD = 2048;
constexpr float EPSN = 1e-6f;
#ifndef MK_WGM_DOWN
#define MK_WGM_DOWN 2
#endif
#ifndef MK_YSCALE
#define MK_YSCALE 1.0f
#endif
constexpr float QSCALE = 0.07216878364870322f * 1.4426950408889634f;
constexpr size_t O_YP = 0, O_YS = 67108864, O_SRP = 69206016, O_CKP = 70254592, O_KRP = 78643200, O_SRS = 79691776, O_CKS = 83886080, O_KRS = 84148224, O_END = 84180992;
constexpr size_t MiB = 1u << 20;
constexpr size_t WS_CTL = 0, CTL_ZERO_BYTES = 1 * MiB;
constexpr size_t WS_W1GU = 1 * MiB;
constexpr size_t WS_W1D  = WS_W1GU + 172 * MiB;
constexpr size_t WS_KN   = WS_W1GU;
constexpr size_t WS_VT   = WS_W1GU + 98 * MiB;
constexpr size_t WS_W2GU = WS_W1D + 86 * MiB;
constexpr size_t WS_W2D  = WS_W2GU + 172 * MiB;
constexpr size_t WS_WIN  = WS_W2D + 86 * MiB;
constexpr size_t WS_WUQ  = WS_WIN + 78 * MiB;
constexpr size_t WS_WUK  = WS_WUQ + 6 * MiB;
constexpr size_t WS_WUV  = WS_WUK + 2 * MiB;
constexpr size_t WS_WOUT = WS_WUV + 2 * MiB;
constexpr size_t WS_XN   = WS_WOUT + 32 * MiB;
constexpr size_t WS_HID  = WS_XN + 132 * MiB;
constexpr size_t WS_Z    = WS_HID;
constexpr size_t WS_QAN  = WS_HID + 322 * MiB;
constexpr size_t WS_QH   = WS_HID + 355 * MiB;
constexpr size_t WS_CALL = WS_QH + 99 * MiB;
constexpr size_t WS_KR   = WS_CALL + 25 * MiB;
constexpr size_t WS_TAB  = WS_KR + 4 * MiB;
constexpr size_t WS_SLAB = WS_TAB + 10 * MiB;
constexpr size_t WS_HB   = WS_SLAB + 64 * MiB;
constexpr size_t WS_END  = WS_HB + 132 * MiB;
static_assert((size_t)TT * ZLD * 2 <= 322 * MiB && (size_t)TT * 1024 * 2 <= 33 * MiB && (size_t)TT * DFF * 2 <= 355 * MiB && (size_t)KROWS * 2048 * 2 <= 98 * MiB, "ws map");
constexpr int CW_QUEUE = 64;
constexpr int CW_BGQ = 2048;
constexpr int CW_BAR = 4096;
constexpr int RING_BYTES = 131072, MISC_OFF = RING_BYTES + 320, LDS_BYTES = 147456;

#define GAS __attribute__((address_space(1)))
#define LAS __attribute__((address_space(3)))
typedef unsigned short bf16;
typedef unsigned v4u __attribute__((ext_vector_type(4)));
typedef unsigned v2u __attribute__((ext_vector_type(2)));
typedef float f32x4 __attribute__((ext_vector_type(4)));
typedef float f32x16 __attribute__((ext_vector_type(16)));
typedef short bf16x8 __attribute__((ext_vector_type(8)));
typedef short s16x4 __attribute__((ext_vector_type(4)));
#define LDS_WAIT() asm volatile("s_waitcnt lgkmcnt(0)" ::: "memory")
#define VM_WAIT() asm volatile("s_waitcnt vmcnt(0)" ::: "memory")
__device__ __forceinline__ unsigned f2bf(float f) { unsigned u = __builtin_bit_cast(unsigned, f); return (u + 0x7fffu + ((u >> 16) & 1u)) >> 16; }
__device__ __forceinline__ unsigned pk2(float lo, float hi) { return pg8::cvt_pk_bf16(lo, hi); }
__device__ __forceinline__ float bflo(unsigned w) { return __builtin_bit_cast(float, w << 16); }
__device__ __forceinline__ float bfhi(unsigned w) { return __builtin_bit_cast(float, w & 0xffff0000u); }
__device__ __forceinline__ float ex2(float x) { return __builtin_amdgcn_exp2f(x); }
#define XB_TMO      128
#define XB_XCNT(j)  (256  + 64 * (j))
#define XB_XSUB(j)  (1280 + 64 * (j))
#define XB_XGEN(j)  (2304 + 64 * (j))
#define XB_TOP      3328
#define XB_TOPGEN   3392
#define XCD_BAR_WORDS 3456
#define XB_SPIN_CAP (1u << 18)

__device__ __forceinline__ unsigned xb_ld(unsigned* p)              { return __hip_atomic_load(p, __ATOMIC_RELAXED, __HIP_MEMORY_SCOPE_AGENT); }
__device__ __forceinline__ unsigned xb_add(unsigned* p, unsigned v) { return __hip_atomic_fetch_add(p, v, __ATOMIC_RELAXED, __HIP_MEMORY_SCOPE_AGENT); }
__device__ __forceinline__ unsigned xb_xcc_id() { return (unsigned)__builtin_amdgcn_s_getreg((3 << 11) | 20) & 0xFu; }
#define XB_SPIN(cond, bar) do { unsigned _sp = 0; while (cond) { __builtin_amdgcn_s_sleep(1); \
    if ((++_sp & 255u) == 0u) { if (xb_ld(&(bar)[XB_TMO])) break; if (_sp > XB_SPIN_CAP) { atomicAdd(&(bar)[XB_TMO], 1u); break; } } } } while (0)

struct XcdBarrier {
    unsigned* bar; unsigned x;
    volatile LAS unsigned* st;
};

__device__ __forceinline__ XcdBarrier xcd_barrier_post(unsigned* bar, volatile LAS unsigned* st) {
    XcdBarrier b; b.bar = bar; b.x = xb_xcc_id(); b.st = st;
    if (threadIdx.x == 0) (void)xb_add(&bar[XB_XCNT(b.x)], 1u);
    return b;
}
__device__ __forceinline__ void xcd_barrier_complete(unsigned* bar, unsigned x, unsigned& nloc, unsigned& nx) {
    const unsigned G = gridDim.x * gridDim.y * gridDim.z;
    unsigned sum, cnt, mine, sp = 0u;
    for (;;) {
        sum = 0u; cnt = 0u; mine = 0u;
#pragma unroll
        for (unsigned j = 0; j < 16; ++j) { const unsigned c = xb_ld(&bar[XB_XCNT(j)]); sum += c; cnt += (c > 0u) ? 1u : 0u; mine = (j == x) ? c : mine; }
        if (sum == G) break;
        __builtin_amdgcn_s_sleep(1);
        if ((++sp & 255u) == 0u) { if (xb_ld(&bar[XB_TMO])) break; if (sp > XB_SPIN_CAP) { atomicAdd(&bar[XB_TMO], 1u); break; } }
    }
    nloc = mine > 0u ? mine : 1u; nx = cnt > 0u ? cnt : 1u;
}

__device__ __forceinline__ void xcd_barrier(const XcdBarrier& b) {
    asm volatile("s_waitcnt vmcnt(0)" ::: "memory");
    __syncthreads();
    if (threadIdx.x == 0) {
        unsigned* bar = b.bar;
        __builtin_amdgcn_s_waitcnt(0);
        unsigned nloc = b.st[0], nx = b.st[1];
        if (nloc == 0u) { xcd_barrier_complete(bar, b.x, nloc, nx); b.st[0] = nloc; b.st[1] = nx; }
        const unsigned old = xb_add(&bar[XB_XSUB(b.x)], 1u);
        const unsigned gen = old / nloc;
        if (old + 1u == (gen + 1u) * nloc) {
            __builtin_amdgcn_fence(__ATOMIC_RELEASE, "agent");
            asm volatile("s_waitcnt vmcnt(0)" ::: "memory");
            const unsigned og = xb_add(&bar[XB_TOP], 1u);
            const unsigned tg = og / nx;
            if (og + 1u == (tg + 1u) * nx) xb_add(&bar[XB_TOPGEN], 1u);
            else XB_SPIN(xb_ld(&bar[XB_TOPGEN]) == tg, bar);
            __builtin_amdgcn_fence(__ATOMIC_ACQUIRE, "agent");
            xb_add(&bar[XB_XGEN(b.x)], 1u);
            asm volatile("s_waitcnt vmcnt(0)" ::: "memory");
        } else {
            XB_SPIN(xb_ld(&bar[XB_XGEN(b.x)]) == gen, bar);
            __builtin_amdgcn_fence(__ATOMIC_ACQUIRE, "agent");
            asm volatile("s_waitcnt vmcnt(0)" ::: "memory");
        }
    }
    __syncthreads();
}

__device__ __forceinline__ float wave_sum(float v) {
#pragma unroll
    for (int o = 1; o < 64; o <<= 1) v += __shfl_xor(v, o);
    return v;
}
__device__ __forceinline__ void tr_load(f32x4 (&wv)[8], const float* __restrict__ W, int N, int k0, int n0, int lane) {
#pragma unroll
    for (int i = 0; i < 8; ++i) wv[i] = *(const GAS f32x4*)(W + (size_t)(k0 + 8 * i + (lane >> 3)) * N + n0 + 4 * (lane & 7));
}
__device__ __forceinline__ void tr_store(const f32x4 (&wv)[8], int K, bf16* dst, LAS float* scr, int k0, int lane) {
#pragma unroll
    for (int i = 0; i < 8; ++i) { LAS float* d = scr + (8 * i + (lane >> 3)) * 33 + 4 * (lane & 7); d[0] = wv[i].x; d[1] = wv[i].y; d[2] = wv[i].z; d[3] = wv[i].w; }
    LDS_WAIT(); asm volatile("" ::: "memory");
    const int c = lane & 7;
#pragma unroll
    for (int j = 0; j < 4; ++j) { const int n = (lane >> 3) + 8 * j; const LAS float* s = scr + (8 * c) * 33 + n;
        v4u o; o.x = pk2(s[0 * 33], s[1 * 33]); o.y = pk2(s[2 * 33], s[3 * 33]); o.z = pk2(s[4 * 33], s[5 * 33]); o.w = pk2(s[6 * 33], s[7 * 33]);
        *(GAS v4u*)(dst + (size_t)n * K + k0 + 8 * c) = o; }
    LDS_WAIT(); asm volatile("" ::: "memory");
}
__device__ __forceinline__ void convert_decode(int K, int N, int mode, bf16* dstA, bf16* dstB, int it, int& k0, int& n0, bf16*& d) {
    const int nblk = N / 32;
    const int kb = it / nblk, nb = it - kb * nblk; n0 = 32 * nb; k0 = 64 * kb;
    if (mode == 0) d = dstA + (size_t)n0 * K;
    else if (mode == 1) d = dstA + (size_t)(256 * (n0 >> 7) + (n0 & 127)) * K;
    else if (mode == 2) d = dstA + (size_t)(256 * (n0 >> 7) + 128 + (n0 & 127)) * K;
    else { const int hh = n0 >> 8, x = n0 & 255; d = (x < 128) ? dstA + (size_t)(hh * 128 + x) * K : dstB + (size_t)(hh * 128 + x - 128) * K; }
}
__device__ __forceinline__ void convert_item(const float* __restrict__ W, int K, int N, int mode, bf16* dstA, bf16* dstB, LAS float* scr, int it, int lane) {
    int k0, n0; bf16* d; convert_decode(K, N, mode, dstA, dstB, it, k0, n0, d);
    f32x4 wv[8]; tr_load(wv, W, N, k0, n0, lane); tr_store(wv, K, d, scr, k0, lane);
}
__device__ __forceinline__ void convert_items4(const float* __restrict__ W, int K, int N, int mode, bf16* dstA, bf16* dstB, LAS float* scr, int it, int lane) {
    int k0[4], n0[4]; bf16* d[4]; f32x4 wv[4][8];
#pragma unroll
    for (int b = 0; b < 4; ++b) { convert_decode(K, N, mode, dstA, dstB, it + b, k0[b], n0[b], d[b]); tr_load(wv[b], W, N, k0[b], n0[b], lane); }
#pragma unroll
    for (int b = 0; b < 4; ++b) tr_store(wv[b], K, d[b], scr, k0[b], lane);
}
__device__ __forceinline__ void convert_weight(const float* __restrict__ W, int K, int N, int mode, bf16* dstA, bf16* dstB, LAS float* scr, int gw, int NGW, int lane) {
    const int nitems = (K / 64) * (N / 32);
    for (int it = gw; it < nitems; it += NGW) convert_item(W, K, N, mode, dstA, dstB, scr, it, lane);
}
__device__ __forceinline__ void sincos_tab(int pos, int i, int n, float& c, float& s) {
    const float inv = __builtin_exp2f(-(float)i * (13.287712379549449f / (float)n));
    const double ang = (double)pos * (double)inv;
    const double k = __builtin_rint(ang * 0.63661977236758134);
    const double r = (ang - k * 1.5707963267948966) - k * 6.123233995736766e-17;
    const double r2 = r * r;
    const double sn = r * (1.0 + r2 * (-1.0 / 6 + r2 * (1.0 / 120 + r2 * (-1.0 / 5040 + r2 * (1.0 / 362880 + r2 * (-1.0 / 39916800))))));
    const double cs = 1.0 + r2 * (-0.5 + r2 * (1.0 / 24 + r2 * (-1.0 / 720 + r2 * (1.0 / 40320 + r2 * (-1.0 / 3628800 + r2 * (1.0 / 479001600))))));
    const int q = ((int)k) & 3;
    const double cc = (q == 0) ? cs : (q == 1) ? -sn : (q == 2) ? -cs : sn;
    const double ss = (q == 0) ? sn : (q == 1) ? cs : (q == 2) ? -sn : -cs;
    c = (float)cc; s = (float)ss;
}
__device__ __forceinline__ void build_split_tab(LAS unsigned char* tab, int G, int K, int tid, int wgm) {
    for (int i = tid; i < 66 * 16; i += 512) tab[i] = 0xff;
    __syncthreads();
    pg8::SplitTailOrder S; S.init(TT, DM, G, 0, K); S.wgm = wgm; const int R = S.nwg / G, rem = S.nwg - R * G;
    if (tid < rem) { pg8::Unit u; S.tile(R * G + tid, u); tab[u.pm * 16 + u.pn] = (unsigned char)tid; }
    __syncthreads();
    if (tid < 66) { unsigned m = 0u;
        for (int j = 0; j < 16; ++j) m |= (tab[tid * 16 + j] != 0xff ? 1u : 0u) << j;
        ((LAS unsigned short*)(tab + 1088))[tid] = (unsigned short)m; }
    __syncthreads();
}
__device__ __forceinline__ void split_fixup(f32x4 (&v)[16], float* hrow, int r, const LAS unsigned char* tab, const float* __restrict__ slabs, float alpha, int lane) {
    const int pm = r >> 8;
#pragma unroll
    for (int j = 0; j < 16; ++j) {
        const int slot = __builtin_amdgcn_readfirstlane((int)tab[pm * 16 + j]);
        if (slot != 0xff) {
            const GAS f32x4* sp = (const GAS f32x4*)(slabs + (size_t)slot * 8 * 65536 + (size_t)(r & 255) * 256) + lane;
            f32x4 a = sp[0];
#pragma unroll
            for (int p = 1; p < 8; ++p) a = a + sp[(size_t)p * 16384];
            v[j] = v[j] + alpha * a;
            ((GAS f32x4*)hrow)[lane + 64 * j] = v[j];
        }
    }
}
template <bool FIX>
__device__ __forceinline__ void rms_row_bf16(float* xrow, const float* __restrict__ g, bf16* orow, int lane, int r, const LAS unsigned char* tab, const float* slabs, float alpha) {
    const GAS f32x4* xr = (const GAS f32x4*)xrow + lane;
    f32x4 v[16]; float s = 0.f;
#pragma unroll
    for (int j = 0; j < 16; ++j) v[j] = xr[64 * j];
    if (FIX) split_fixup(v, xrow, r, tab, slabs, alpha, lane);
#pragma unroll
    for (int j = 0; j < 16; ++j) s += (v[j].x * v[j].x + v[j].y * v[j].y) + (v[j].z * v[j].z + v[j].w * v[j].w);
    const float rinv = 1.0f / sqrtf(wave_sum(s) * (1.0f / 4096.0f) + EPSN);
    const GAS f32x4* gr = (const GAS f32x4*)g + lane;
    GAS v2u* o8 = (GAS v2u*)orow + lane;
#pragma unroll
    for (int j = 0; j < 16; ++j) { const f32x4 gv = gr[64 * j]; v2u w; w.x = pk2(v[j].x * rinv * gv.x, v[j].y * rinv * gv.y); w.y = pk2(v[j].z * rinv * gv.z, v[j].w * rinv * gv.w); o8[64 * j] = w; }
}
__device__ __forceinline__ void rms_row_f32_inplace(float* xrow, const float* __restrict__ g, int lane, int r, const LAS unsigned char* tab, const float* slabs, float alpha) {
    GAS f32x4* xr = (GAS f32x4*)xrow + lane;
    f32x4 v[16]; float s = 0.f;
#pragma unroll
    for (int j = 0; j < 16; ++j) v[j] = xr[64 * j];
    split_fixup(v, xrow, r, tab, slabs, alpha, lane);
#pragma unroll
    for (int j = 0; j < 16; ++j) s += (v[j].x * v[j].x + v[j].y * v[j].y) + (v[j].z * v[j].z + v[j].w * v[j].w);
    const float rinv = 1.0f / sqrtf(wave_sum(s) * (1.0f / 4096.0f) + EPSN);
    const GAS f32x4* gr = (const GAS f32x4*)g + lane;
#pragma unroll
    for (int j = 0; j < 16; ++j) { const f32x4 gv = gr[64 * j]; xr[64 * j] = v[j] * rinv * gv * MK_YSCALE; }
}
template <bool FIX, bool TO_BF16>
__device__ __forceinline__ void norm_phase(const float* x_p, const float* x_s  , const float* __restrict__ g, bf16* XNo, float* fout,
                                           int gw, int NGW, int lane, const LAS unsigned char* tab, const float* slabs, float alpha) {
    f32x4 gv[16], v[16], nx[16];
    constexpr bool W8 = TO_BF16 && !FIX;
#define NP_IDX(j) (W8 ? (2 * lane + 128 * ((j) >> 1) + ((j) & 1)) : (lane + 64 * (j)))
    { const GAS f32x4* gr = (const GAS f32x4*)g;
#pragma unroll
      for (int j = 0; j < 16; ++j) gv[j] = gr[NP_IDX(j)]; }
#define NP_LOAD(dst, rr) do { const GAS f32x4* xr_ = (const GAS f32x4*)((rr) < TP ? x_p + (size_t)(rr) * DM : x_s + (size_t)((rr) - TP) * DM); _Pragma("unroll") for (int j = 0; j < 16; ++j) dst[j] = xr_[NP_IDX(j)]; } while (0)
    int r = gw;
    if (r < TT) NP_LOAD(v, r);
    for (; r < TT; r += NGW) {
        if (r + NGW < TT) NP_LOAD(nx, r + NGW);
        if (FIX) split_fixup(v, fout + (size_t)r * DM, r, tab, slabs, alpha, lane);
        float s = 0.f;
#pragma unroll
        for (int j = 0; j < 16; ++j) s += (v[j].x * v[j].x + v[j].y * v[j].y) + (v[j].z * v[j].z + v[j].w * v[j].w);
        const float rinv = 1.0f / sqrtf(wave_sum(s) * (1.0f / 4096.0f) + EPSN);
        if (W8) { GAS v4u* o16 = (GAS v4u*)(XNo + (size_t)r * DM) + lane;
#pragma unroll
            for (int jj = 0; jj < 8; ++jj) { const f32x4 a = v[2 * jj] * rinv * gv[2 * jj], b = v[2 * jj + 1] * rinv * gv[2 * jj + 1];
                v4u w; w.x = pk2(a.x, a.y); w.y = pk2(a.z, a.w); w.z = pk2(b.x, b.y); w.w = pk2(b.z, b.w); o16[64 * jj] = w; }
        } else if (TO_BF16) { GAS v2u* o8 = (GAS v2u*)(XNo + (size_t)r * DM) + lane;
#pragma unroll
            for (int j = 0; j < 16; ++j) { v2u w; w.x = pk2(v[j].x * rinv * gv[j].x, v[j].y * rinv * gv[j].y); w.y = pk2(v[j].z * rinv * gv[j].z, v[j].w * rinv * gv[j].w); o8[64 * j] = w; }
        } else { GAS f32x4* xr = (GAS f32x4*)(fout + (size_t)r * DM) + lane;
#pragma unroll
            for (int j = 0; j < 16; ++j) xr[64 * j] = v[j] * rinv * gv[j] * MK_YSCALE; }
#pragma unroll
        for (int j = 0; j < 16; ++j) v[j] = nx[j];
    }
#undef NP_LOAD
#undef NP_IDX
}
template <bool TO_BF16>
__device__ __forceinline__ void norm_phase_h(bf16* HB, const float* __restrict__ g, bf16* XNo, float* yout, int gw, int NGW, int lane, const LAS unsigned char* tab, const float* __restrict__ slabs, float alpha, int S) {
    f32x4 g0[8], g1[8]; v4u v[8], nx[8];
#pragma unroll
    for (int j = 0; j < 8; ++j) { const GAS f32x4* gp = (const GAS f32x4*)(g + 8 * (lane + 64 * j)); g0[j] = gp[0]; g1[j] = gp[1]; }
#define NH_LOAD(dst, rr) do { const GAS v4u* hr_ = (const GAS v4u*)(HB + (size_t)(rr) * DM) + lane; _Pragma("unroll") for (int j = 0; j < 8; ++j) dst[j] = hr_[64 * j]; } while (0)
    int r = gw;
    if (r < TT) NH_LOAD(v, r);
    for (; r < TT; r += NGW) {
        if (r + NGW < TT) NH_LOAD(nx, r + NGW);
        const int pm = r >> 8; float s = 0.f;
        const unsigned pmask = (unsigned)__builtin_amdgcn_readfirstlane((int)((const LAS unsigned short*)(tab + 1088))[pm]);
#pragma unroll
        for (int j = 0; j < 8; ++j) {
            f32x4 a0 = (f32x4){bflo(v[j].x), bfhi(v[j].x), bflo(v[j].y), bfhi(v[j].y)}, a1 = (f32x4){bflo(v[j].z), bfhi(v[j].z), bflo(v[j].w), bfhi(v[j].w)};
            if ((pmask >> (2 * j)) & 3u) {
                const int sl0 = __builtin_amdgcn_readfirstlane((int)tab[pm * 16 + 2 * j]), sl1 = __builtin_amdgcn_readfirstlane((int)tab[pm * 16 + 2 * j + 1]);
                const int slot = lane < 32 ? sl0 : sl1;
                if (slot != 0xff) {
                    const GAS v4u* sp = (const GAS v4u*)((const bf16*)slabs + (size_t)slot * S * 65536 + (size_t)(r & 255) * 256 + 8 * (lane & 31));
                    v4u pw[8];
#pragma unroll
                    for (int p = 0; p < 8; ++p) if (p < S) pw[p] = sp[(size_t)p * 8192];
                    f32x4 p0 = (f32x4){bflo(pw[0].x), bfhi(pw[0].x), bflo(pw[0].y), bfhi(pw[0].y)}, p1 = (f32x4){bflo(pw[0].z), bfhi(pw[0].z), bflo(pw[0].w), bfhi(pw[0].w)};
#pragma unroll
                    for (int p = 1; p < 8; ++p) if (p < S) { p0 = p0 + (f32x4){bflo(pw[p].x), bfhi(pw[p].x), bflo(pw[p].y), bfhi(pw[p].y)}; p1 = p1 + (f32x4){bflo(pw[p].z), bfhi(pw[p].z), bflo(pw[p].w), bfhi(pw[p].w)}; }
                    a0 = a0 + alpha * p0; a1 = a1 + alpha * p1;
                    v4u w; w.x = pk2(a0.x, a0.y); w.y = pk2(a0.z, a0.w); w.z = pk2(a1.x, a1.y); w.w = pk2(a1.z, a1.w);
                    ((GAS v4u*)(HB + (size_t)r * DM))[lane + 64 * j] = w;
                    a0 = (f32x4){bflo(w.x), bfhi(w.x), bflo(w.y), bfhi(w.y)}; a1 = (f32x4){bflo(w.z), bfhi(w.z), bflo(w.w), bfhi(w.w)};
                    v[j] = w;
                }
            }
            s += (a0.x * a0.x + a0.y * a0.y) + (a0.z * a0.z + a0.w * a0.w) + (a1.x * a1.x + a1.y * a1.y) + (a1.z * a1.z + a1.w * a1.w);
        }
        const float rinv = 1.0f / sqrtf(wave_sum(s) * (1.0f / 4096.0f) + EPSN);
#pragma unroll
        for (int j = 0; j < 8; ++j) {
            const f32x4 o0 = (f32x4){bflo(v[j].x), bfhi(v[j].x), bflo(v[j].y), bfhi(v[j].y)} * rinv * g0[j], o1 = (f32x4){bflo(v[j].z), bfhi(v[j].z), bflo(v[j].w), bfhi(v[j].w)} * rinv * g1[j];
            if (TO_BF16) { v4u w; w.x = pk2(o0.x, o0.y); w.y = pk2(o0.z, o0.w); w.z = pk2(o1.x, o1.y); w.w = pk2(o1.z, o1.w); ((GAS v4u*)(XNo + (size_t)r * DM))[lane + 64 * j] = w; }
            else { GAS f32x4* yp = (GAS f32x4*)(yout + (size_t)r * DM + 8 * (lane + 64 * j)); yp[0] = o0 * MK_YSCALE; yp[1] = o1 * MK_YSCALE; }
        }
#pragma unroll
        for (int j = 0; j < 8; ++j) v[j] = nx[j];
    }
#undef NH_LOAD
}
__device__ __forceinline__ void norm_phase_y(bf16* HB, const float* __restrict__ g, float* yout, int gw, int NGW, int lane, const LAS unsigned char* tab, const float* __restrict__ slabs, float alpha, int S) {
    f32x4 gg[16]; v2u v[16], nx[16];
#pragma unroll
    for (int jj = 0; jj < 16; ++jj) gg[jj] = *(const GAS f32x4*)(g + 256 * jj + 4 * lane);
#define NY_LOAD(dst, rr) do { const GAS v2u* hr_ = (const GAS v2u*)(HB + (size_t)(rr) * DM) + lane; _Pragma("unroll") for (int jj = 0; jj < 16; ++jj) dst[jj] = hr_[64 * jj]; } while (0)
    int r = gw;
    if (r < TT) NY_LOAD(v, r);
    for (; r < TT; r += NGW) {
        if (r + NGW < TT) NY_LOAD(nx, r + NGW);
        const int pm = r >> 8; float s = 0.f;
        const unsigned pmask = (unsigned)__builtin_amdgcn_readfirstlane((int)((const LAS unsigned short*)(tab + 1088))[pm]);
#pragma unroll
        for (int jj = 0; jj < 16; ++jj) {
            f32x4 a = (f32x4){bflo(v[jj].x), bfhi(v[jj].x), bflo(v[jj].y), bfhi(v[jj].y)};
            if ((pmask >> jj) & 1u) {
                const int slot = __builtin_amdgcn_readfirstlane((int)tab[pm * 16 + jj]);
                const GAS v2u* sp = (const GAS v2u*)((const bf16*)slabs + (size_t)slot * S * 65536 + (size_t)(r & 255) * 256 + 4 * lane);
                f32x4 ps = (f32x4){0.f, 0.f, 0.f, 0.f};
#pragma unroll
                for (int p = 0; p < 8; ++p) if (p < S) { const v2u w = sp[(size_t)p * 16384]; ps = ps + (f32x4){bflo(w.x), bfhi(w.x), bflo(w.y), bfhi(w.y)}; }
                a = a + alpha * ps;
                v2u w; w.x = pk2(a.x, a.y); w.y = pk2(a.z, a.w);
                ((GAS v2u*)(HB + (size_t)r * DM))[lane + 64 * jj] = w;
                a = (f32x4){bflo(w.x), bfhi(w.x), bflo(w.y), bfhi(w.y)}; v[jj] = w;
            }
            s += (a.x * a.x + a.y * a.y) + (a.z * a.z + a.w * a.w);
        }
        const float rinv = 1.0f / sqrtf(wave_sum(s) * (1.0f / 4096.0f) + EPSN);
#pragma unroll
        for (int jj = 0; jj < 16; ++jj) { const f32x4 o = (f32x4){bflo(v[jj].x), bfhi(v[jj].x), bflo(v[jj].y), bfhi(v[jj].y)} * rinv * gg[jj];
            *(GAS f32x4*)(yout + (size_t)r * DM + 256 * jj + 4 * lane) = o * MK_YSCALE; }
#pragma unroll
        for (int jj = 0; jj < 16; ++jj) v[jj] = nx[jj];
    }
#undef NY_LOAD
}
__device__ __forceinline__ int pos_of_row(int r) { return r < TP ? (r & (SEQ - 1)) : 1024 + ((r - TP) & 63); }
__device__ __forceinline__ int crow_of_row(int r) { return r < TP ? r : TP + 1088 * ((r - TP) >> 6) + 1024 + ((r - TP) & 63); }

typedef short v4i16_t __attribute__((ext_vector_type(4)));
__device__ __forceinline__ bf16x8 tr_frag(const LAS unsigned char* img, int stride, int row0, int col0, int li, int q4) {
    const LAS unsigned char* p = img + (row0 + 8 * q4 + (li >> 2)) * stride + (col0 + 4 * (li & 3)) * 2;
    const v4i16_t a = __builtin_amdgcn_ds_read_tr16_b64_v4i16((LAS v4i16_t*)p);
    const v4i16_t b = __builtin_amdgcn_ds_read_tr16_b64_v4i16((LAS v4i16_t*)(p + 4 * stride));
    bf16x8 r; r[0] = a[0]; r[1] = a[1]; r[2] = a[2]; r[3] = a[3]; r[4] = b[0]; r[5] = b[1]; r[6] = b[2]; r[7] = b[3]; return r;
}

constexpr int R_QS = 0, R_KS = 33792, R_VS = 67584, R_V2 = 84992, R_PS = 102400, R_QSTR = 528, R_VSTR = 272, R_PSTR = 144;
__device__ __forceinline__ void ret_unit(LAS unsigned char* lds, int kind, int bidx, int h, int half, const bf16* __restrict__ Z, bf16* OM, const float* __restrict__ S0, float* Sout, int tid) {
    const int wid = __builtin_amdgcn_readfirstlane(tid >> 6), lane = tid & 63, li = lane & 15, q4 = lane >> 4;
    const int nchunks = kind == 0 ? 128 : 1;
    const int row0 = kind == 0 ? bidx * SEQ : TP + 64 * bidx;
    const float lg = __builtin_log2f(1.0f - ex2(-5.0f - (float)h));
    const int cw = 128 * half + 16 * wid;
    f32x4 S[16];
    if (kind == 0) {
#pragma unroll
        for (int j = 0; j < 16; ++j) S[j] = (f32x4){0.f, 0.f, 0.f, 0.f};
    } else {
        const float* sp = S0 + ((size_t)(bidx * 8 + h) * 256) * 256 + cw + li;
#pragma unroll
        for (int j = 0; j < 16; ++j)
#pragma unroll
            for (int r = 0; r < 4; ++r) S[j][r] = sp[(size_t)(16 * j + 4 * q4 + r) * 256];
    }
    v4u rq[4], rk[4], rv[2];
    const int qrow = tid >> 5, qc = tid & 31, vrow = tid >> 4, vc = tid & 15;
#define RET_LOAD(c) do { const bf16* zb = Z + (size_t)(row0 + 64 * (c)) * ZLD + h * 256; \
        _Pragma("unroll") for (int i = 0; i < 4; ++i) { rq[i] = *(const GAS v4u*)(zb + (size_t)(qrow + 16 * i) * ZLD + 8 * qc); rk[i] = *(const GAS v4u*)(zb + (size_t)(qrow + 16 * i) * ZLD + 2048 + 8 * qc); } \
        _Pragma("unroll") for (int i = 0; i < 2; ++i) rv[i] = *(const GAS v4u*)(zb + (size_t)(vrow + 32 * i) * ZLD + 4096 + 128 * half + 8 * vc); } while (0)
    RET_LOAD(0);
    const float g64 = ex2(64.0f * lg);
    for (int c = 0; c < nchunks; ++c) {
        __syncthreads();
#pragma unroll
        for (int i = 0; i < 4; ++i) { *(LAS v4u*)(lds + R_QS + (qrow + 16 * i) * R_QSTR + 16 * qc) = rq[i]; *(LAS v4u*)(lds + R_KS + (qrow + 16 * i) * R_QSTR + 16 * qc) = rk[i]; }
#pragma unroll
        for (int i = 0; i < 2; ++i) { const int row = vrow + 32 * i; *(LAS v4u*)(lds + R_VS + row * R_VSTR + 16 * vc) = rv[i];
            const float sc = ex2((float)(63 - row) * lg); v4u w;
            w.x = pk2(bflo(rv[i].x) * sc, bfhi(rv[i].x) * sc); w.y = pk2(bflo(rv[i].y) * sc, bfhi(rv[i].y) * sc); w.z = pk2(bflo(rv[i].z) * sc, bfhi(rv[i].z) * sc); w.w = pk2(bflo(rv[i].w) * sc, bfhi(rv[i].w) * sc);
            *(LAS v4u*)(lds + R_V2 + row * R_VSTR + 16 * vc) = w; }
        __syncthreads();
        if (c + 1 < nchunks) RET_LOAD(c + 1);
        {
            const int bi = wid >> 1, bj0 = 2 * (wid & 1);
            f32x4 p0 = (f32x4){0.f, 0.f, 0.f, 0.f}, p1 = p0;
#pragma unroll
            for (int ks = 0; ks < 8; ++ks) {
                const bf16x8 a = *(const LAS bf16x8*)(lds + R_QS + (16 * bi + li) * R_QSTR + (32 * ks + 8 * q4) * 2);
                const bf16x8 b0 = *(const LAS bf16x8*)(lds + R_KS + (16 * bj0 + li) * R_QSTR + (32 * ks + 8 * q4) * 2);
                const bf16x8 b1 = *(const LAS bf16x8*)(lds + R_KS + (16 * bj0 + 16 + li) * R_QSTR + (32 * ks + 8 * q4) * 2);
                p0 = __builtin_amdgcn_mfma_f32_16x16x32_bf16(a, b0, p0, 0, 0, 0);
                p1 = __builtin_amdgcn_mfma_f32_16x16x32_bf16(a, b1, p1, 0, 0, 0);
            }
#pragma unroll
            for (int r = 0; r < 4; ++r) { const int l = 16 * bi + 4 * q4 + r, m0 = 16 * bj0 + li, m1 = m0 + 16;
                const float v0 = (l >= m0) ? p0[r] * ex2((float)(l - m0) * lg) : 0.f, v1 = (l >= m1) ? p1[r] * ex2((float)(l - m1) * lg) : 0.f;
                *(LAS unsigned short*)(lds + R_PS + l * R_PSTR + m0 * 2) = (unsigned short)f2bf(v0);
                *(LAS unsigned short*)(lds + R_PS + l * R_PSTR + m1 * 2) = (unsigned short)f2bf(v1); }
        }
        __syncthreads();
        {
            f32x4 o[4];
#pragma unroll
            for (int tb = 0; tb < 4; ++tb) o[tb] = (f32x4){0.f, 0.f, 0.f, 0.f};
#pragma unroll
            for (int ks = 0; ks < 8; ++ks) {
                v4u sw; sw.x = pk2(S[2 * ks][0], S[2 * ks][1]); sw.y = pk2(S[2 * ks][2], S[2 * ks][3]); sw.z = pk2(S[2 * ks + 1][0], S[2 * ks + 1][1]); sw.w = pk2(S[2 * ks + 1][2], S[2 * ks + 1][3]);
                const bf16x8 sb = __builtin_bit_cast(bf16x8, sw);
#pragma unroll
                for (int tb = 0; tb < 4; ++tb) {
                    const v2u lo = *(const LAS v2u*)(lds + R_QS + (16 * tb + li) * R_QSTR + (32 * ks + 4 * q4) * 2);
                    const v2u hi = *(const LAS v2u*)(lds + R_QS + (16 * tb + li) * R_QSTR + (32 * ks + 16 + 4 * q4) * 2);
                    v4u w; w.x = lo.x; w.y = lo.y; w.z = hi.x; w.w = hi.y;
                    o[tb] = __builtin_amdgcn_mfma_f32_16x16x32_bf16(sb, __builtin_bit_cast(bf16x8, w), o[tb], 0, 0, 0);
                }
            }
            const bf16x8 vf0 = tr_frag(lds + R_VS, R_VSTR, 0, 16 * wid, li, q4), vf1 = tr_frag(lds + R_VS, R_VSTR, 32, 16 * wid, li, q4);
#pragma unroll
            for (int tb = 0; tb < 4; ++tb) {
                o[tb] = o[tb] * ex2((float)(16 * tb + li + 1) * lg);
                const bf16x8 pa0 = *(const LAS bf16x8*)(lds + R_PS + (16 * tb + li) * R_PSTR + (8 * q4) * 2);
                const bf16x8 pa1 = *(const LAS bf16x8*)(lds + R_PS + (16 * tb + li) * R_PSTR + (32 + 8 * q4) * 2);
                o[tb] = __builtin_amdgcn_mfma_f32_16x16x32_bf16(vf0, pa0, o[tb], 0, 0, 0);
                o[tb] = __builtin_amdgcn_mfma_f32_16x16x32_bf16(vf1, pa1, o[tb], 0, 0, 0);
                v2u ow; ow.x = pk2(o[tb][0], o[tb][1]); ow.y = pk2(o[tb][2], o[tb][3]);
                *(GAS v2u*)(OM + (size_t)(row0 + 64 * c + 16 * tb + li) * DM + h * 256 + cw + 4 * q4) = ow;
            }
        }
        {
            const bf16x8 wf0 = tr_frag(lds + R_V2, R_VSTR, 0, 16 * wid, li, q4), wf1 = tr_frag(lds + R_V2, R_VSTR, 32, 16 * wid, li, q4);
#pragma unroll
            for (int j = 0; j < 16; ++j) {
                S[j] = S[j] * g64;
                const bf16x8 k0 = tr_frag(lds + R_KS, R_QSTR, 0, 16 * j, li, q4), k1 = tr_frag(lds + R_KS, R_QSTR, 32, 16 * j, li, q4);
                S[j] = __builtin_amdgcn_mfma_f32_16x16x32_bf16(k0, wf0, S[j], 0, 0, 0);
                S[j] = __builtin_amdgcn_mfma_f32_16x16x32_bf16(k1, wf1, S[j], 0, 0, 0);
            }
        }
    }
#undef RET_LOAD
    float* so = Sout + cw + li;
#pragma unroll
    for (int j = 0; j < 16; ++j)
#pragma unroll
        for (int r = 0; r < 4; ++r) so[(size_t)(16 * j + 4 * q4 + r) * 256] = S[j][r];
}

constexpr int A_NSTR = 272, A_RSTR = 144, A_VSTR = 144, A_KN = 64 * A_NSTR  , A_KR = 64 * A_RSTR  , A_KB = A_KN + A_KR  , A_VB = 128 * A_VSTR  , A_V0 = 3 * A_KB;
constexpr int A_NI_N = 17, A_NI_R = 9, A_NI_V = 18, A_NI = A_NI_N + A_NI_R + A_NI_V;
static_assert(A_KN == A_NI_N * 1024 && A_KR == A_NI_R * 1024 && A_VB == A_NI_V * 1024 && A_V0 + 2 * A_VB <= RING_BYTES, "attention LDS map");
__device__ __forceinline__ void attn_qk(f32x16& p, const LAS unsigned char* kb, int half, const bf16x8 (&q)[12], int n32, int hi) {
#pragma unroll
    for (int r = 0; r < 16; ++r) p[r] = 0.f;
    bf16x8 a[12];
#pragma unroll
    for (int ks = 0; ks < 8; ++ks) a[ks] = *(const LAS bf16x8*)(kb + (32 * half + n32) * A_NSTR + (16 * ks + 8 * hi) * 2);
#pragma unroll
    for (int ks = 0; ks < 4; ++ks) a[8 + ks] = *(const LAS bf16x8*)(kb + A_KN + (32 * half + n32) * A_RSTR + (16 * ks + 8 * hi) * 2);
#pragma unroll
    for (int ks = 0; ks < 12; ++ks) p = __builtin_amdgcn_mfma_f32_32x32x16_bf16(a[ks], q[ks], p, 0, 0, 0);
}
__device__ __forceinline__ float attn_softmax(f32x16& p, float& m_run, float& l_run, bf16x8 (&pa)[2]) {
    float pmax = p[0];
#pragma unroll
    for (int r = 1; r < 16; ++r) pmax = fmaxf(pmax, p[r]);
    { auto rr = __builtin_amdgcn_permlane32_swap(__float_as_uint(pmax), __float_as_uint(pmax), false, false); pmax = fmaxf(__uint_as_float(rr[0]), __uint_as_float(rr[1])); }
    const bool need = (pmax - m_run) > 10.0f;
    const float mn = need ? pmax : m_run, alpha = ex2(m_run - mn); m_run = mn;
    float ps = 0.f;
#pragma unroll
    for (int r = 0; r < 16; ++r) { p[r] = ex2(p[r] - mn); ps += p[r]; }
    { auto rr = __builtin_amdgcn_permlane32_swap(__float_as_uint(ps), __float_as_uint(ps), false, false); ps = __uint_as_float(rr[0]) + __uint_as_float(rr[1]); }
    l_run = l_run * alpha + ps;
#define PK4(P, B_, OUT) do { const unsigned a0_ = pk2(P[B_ + 0], P[B_ + 1]), a1_ = pk2(P[B_ + 2], P[B_ + 3]), b0_ = pk2(P[B_ + 4], P[B_ + 5]), b1_ = pk2(P[B_ + 6], P[B_ + 7]); \
    auto r0_ = __builtin_amdgcn_permlane32_swap(a0_, b0_, false, false); auto r1_ = __builtin_amdgcn_permlane32_swap(a1_, b1_, false, false); \
    v4u w_; w_.x = r0_[0]; w_.y = r1_[0]; w_.z = r0_[1]; w_.w = r1_[1]; OUT = __builtin_bit_cast(bf16x8, w_); } while (0)
    PK4(p, 0, pa[0]); PK4(p, 8, pa[1]);
#undef PK4
    return alpha;
}
__device__ __forceinline__ void attn_pv(f32x16 (&O)[4], const LAS unsigned char* vbh  , const bf16x8 (&pa)[2], float alpha, int n32, int hi) {
    if (__any(alpha != 1.0f)) {
#pragma unroll
        for (int cb = 0; cb < 4; ++cb)
#pragma unroll
            for (int r = 0; r < 16; ++r) O[cb][r] *= alpha;
    }
    bf16x8 v[4][2];
#pragma unroll
    for (int cb = 0; cb < 4; ++cb)
#pragma unroll
        for (int ks = 0; ks < 2; ++ks) v[cb][ks] = *(const LAS bf16x8*)(vbh + (32 * cb + n32) * A_VSTR + (16 * ks + 8 * hi) * 2);
#pragma unroll
    for (int ks = 0; ks < 2; ++ks)
#pragma unroll
        for (int cb = 0; cb < 4; ++cb) O[cb] = __builtin_amdgcn_mfma_f32_32x32x16_bf16(v[cb][ks], pa[ks], O[cb], 0, 0, 0);
}
#define ATT_SCHED() do { __builtin_amdgcn_sched_group_barrier(0x100, 12, 0); _Pragma("unroll") for (int i_ = 0; i_ < 12; ++i_) { __builtin_amdgcn_sched_group_barrier(0x008, 1, 0); __builtin_amdgcn_sched_group_barrier(0x002, 9, 0); } } while (0)
__device__ __forceinline__ void attn_unit(LAS unsigned char* lds, int qrow0, int nqw, int krow0, int ntiles, int wt_base, int h,
                                          const bf16* __restrict__ QH, const bf16* __restrict__ KN, const bf16* __restrict__ KR, const bf16* __restrict__ VT, bf16* OM, int tid,
                                          const float* __restrict__ gqn, const float* __restrict__ gqr, const float* __restrict__ mcos, const float* __restrict__ msin) {
    const int wid = __builtin_amdgcn_readfirstlane(tid >> 6), lane = tid & 63, n32 = lane & 31, hi = lane >> 5;
    const bool active = wid < nqw;
    const int my_tiles = !active ? 0 : (wt_base < 0 ? ntiles : wt_base + (wid >> 1) + 1);
    f32x16 O[4];
#pragma unroll
    for (int cb = 0; cb < 4; ++cb)
#pragma unroll
        for (int r = 0; r < 16; ++r) O[cb][r] = 0.f;
    float m_run = -1e30f, l_run = 0.f;
    unsigned doff[6];
#pragma unroll
    for (int k = 0; k < 6; ++k) { const int sl = wid + 8 * k;
        if (sl < A_NI_N) { const int pp = 64 * sl + lane, row = pp / 17, c = pp - 17 * row; doff[k] = (unsigned)(row * (KNLD * 2) + h * 256 + (c < 16 ? c : 15) * 16); }
        else if (sl < A_NI_N + A_NI_R) { const int pp = 64 * (sl - A_NI_N) + lane, row = pp / 9, c = pp - 9 * row; doff[k] = (unsigned)(row * 128 + (c < 8 ? c : 7) * 16); }
        else { const int pp = 64 * (sl - A_NI_N - A_NI_R) + lane, row = pp / 9, c = pp - 9 * row; doff[k] = (unsigned)((h * 128 + row) * (KROWS * 2) + (c < 8 ? c : 7) * 16); } }
    const int tlast = ntiles - 1;
#define ATT_DMA_K(t, kbi) do { const int jj_ = (t) < tlast ? (t) : tlast; const size_t kr0_ = (size_t)krow0 + 64 * (size_t)jj_; \
        _Pragma("unroll") for (int k = 0; k < 4; ++k) { const int sl = wid + 8 * k; \
            if (sl < A_NI_N) __builtin_amdgcn_global_load_lds((const unsigned*)((const char*)KN + kr0_ * (KNLD * 2) + doff[k]), (LAS unsigned*)(lds + (kbi) * A_KB + sl * 1024), 16, 0, 0); \
            else if (sl < A_NI_N + A_NI_R) __builtin_amdgcn_global_load_lds((const unsigned*)((const char*)KR + kr0_ * 128 + doff[k]), (LAS unsigned*)(lds + (kbi) * A_KB + A_KN + (sl - A_NI_N) * 1024), 16, 0, 0); } } while (0)
#define ATT_DMA_V(t, vbi) do { const int jj_ = (t) < tlast ? (t) : tlast; const size_t kr0_ = (size_t)krow0 + 64 * (size_t)jj_; \
        _Pragma("unroll") for (int k = 3; k < 6; ++k) { const int sl = wid + 8 * k; \
            if (sl >= A_NI_N + A_NI_R && sl < A_NI) __builtin_amdgcn_global_load_lds((const unsigned*)((const char*)VT + kr0_ * 2 + doff[k]), (LAS unsigned*)(lds + A_V0 + (vbi) * A_VB + (sl - A_NI_N - A_NI_R) * 1024), 16, 0, 0); } } while (0)
    __syncthreads();
    ATT_DMA_K(0, 0); ATT_DMA_V(0, 0); ATT_DMA_K(1, 1);
    bf16x8 q[12];
    {
        const int qrow = qrow0 + 32 * (active ? wid : 0) + n32;
        const bf16* qp = QH + (size_t)qrow * QLD + h * 192 + 8 * hi;
        v4u qv[12];
#pragma unroll
        for (int ks = 0; ks < 12; ++ks) qv[ks] = *(const GAS v4u*)(qp + 16 * ks);
        float sn = 0.f, sr = 0.f;
#pragma unroll
        for (int ks = 0; ks < 12; ++ks) { const float a0 = bflo(qv[ks].x), a1 = bfhi(qv[ks].x), a2 = bflo(qv[ks].y), a3 = bfhi(qv[ks].y), a4 = bflo(qv[ks].z), a5 = bfhi(qv[ks].z), a6 = bflo(qv[ks].w), a7 = bfhi(qv[ks].w);
            const float t = (a0 * a0 + a1 * a1) + (a2 * a2 + a3 * a3) + (a4 * a4 + a5 * a5) + (a6 * a6 + a7 * a7); if (ks < 8) sn += t; else sr += t; }
        sn += __shfl_xor(sn, 32); sr += __shfl_xor(sr, 32);
        const float rn = QSCALE / sqrtf(sn * (1.0f / 128.0f) + EPSN), rr = 1.0f / sqrtf(sr * (1.0f / 64.0f) + EPSN);
#pragma unroll
        for (int ks = 0; ks < 8; ++ks) { const GAS f32x4* gp = (const GAS f32x4*)(gqn + 16 * ks + 8 * hi); const f32x4 ga = gp[0], gb = gp[1]; const v4u r = qv[ks]; v4u w;
            w.x = pk2(bflo(r.x) * rn * ga.x, bfhi(r.x) * rn * ga.y); w.y = pk2(bflo(r.y) * rn * ga.z, bfhi(r.y) * rn * ga.w);
            w.z = pk2(bflo(r.z) * rn * gb.x, bfhi(r.z) * rn * gb.y); w.w = pk2(bflo(r.w) * rn * gb.z, bfhi(r.w) * rn * gb.w); qv[ks] = w; asm volatile("" : "+v"(qv[ks])); }
        const int pos = pos_of_row(qrow);
#pragma unroll
        for (int kk = 0; kk < 2; ++kk) {
            const int d0 = 16 * kk + 8 * hi;
            const GAS float* g1p = (const GAS float*)(gqr + d0); const GAS float* g2p = (const GAS float*)(gqr + 32 + d0);
            const GAS float* cp = (const GAS float*)(mcos + pos * 32 + d0); const GAS float* sp = (const GAS float*)(msin + pos * 32 + d0);
            const v4u r1 = qv[8 + kk], r2 = qv[10 + kk]; unsigned w1[4], w2[4];
            const unsigned r1a[4] = {r1.x, r1.y, r1.z, r1.w}, r2a[4] = {r2.x, r2.y, r2.z, r2.w};
#pragma unroll
            for (int i = 0; i < 4; ++i) {
                const float ya = bflo(r1a[i]) * rr * g1p[2 * i], yb = bfhi(r1a[i]) * rr * g1p[2 * i + 1], za = bflo(r2a[i]) * rr * g2p[2 * i], zb = bfhi(r2a[i]) * rr * g2p[2 * i + 1];
                const float ca = cp[2 * i], cb = cp[2 * i + 1], sa = sp[2 * i], sb = sp[2 * i + 1];
                w1[i] = pk2((ya * ca - za * sa) * QSCALE, (yb * cb - zb * sb) * QSCALE); w2[i] = pk2((za * ca + ya * sa) * QSCALE, (zb * cb + yb * sb) * QSCALE); }
            qv[8 + kk] = (v4u){w1[0], w1[1], w1[2], w1[3]}; qv[10 + kk] = (v4u){w2[0], w2[1], w2[2], w2[3]};
        }
#pragma unroll
        for (int ks = 0; ks < 12; ++ks) q[ks] = __builtin_bit_cast(bf16x8, qv[ks]);
    }
    __builtin_amdgcn_sched_barrier(0);
    VM_WAIT(); __syncthreads();
    f32x16 p;
    if (wid >= 4) __builtin_amdgcn_s_setprio(1);
    if (0 < my_tiles) attn_qk(p, lds, 0, q, n32, hi);
    int j = 0, kc = 0;
    for (; j + 1 < my_tiles; ++j) {
        const int k1 = kc == 2 ? 0 : kc + 1, k2 = k1 == 2 ? 0 : k1 + 1;
        ATT_DMA_K(j + 2, k2); ATT_DMA_V(j + 1, (j + 1) & 1);
        const LAS unsigned char* kb = lds + kc * A_KB; const LAS unsigned char* kn = lds + k1 * A_KB; const LAS unsigned char* vb = lds + A_V0 + (j & 1) * A_VB;
        { f32x16 n; bf16x8 pa[2];
          attn_qk(n, kb, 1, q, n32, hi);
          const float alpha = attn_softmax(p, m_run, l_run, pa);
          ATT_SCHED();
          attn_pv(O, vb, pa, alpha, n32, hi);
          p = n; }
        { f32x16 n; bf16x8 pa[2];
          attn_qk(n, kn, 0, q, n32, hi);
          const float alpha = attn_softmax(p, m_run, l_run, pa);
          ATT_SCHED();
          attn_pv(O, vb + 64, pa, alpha, n32, hi);
          p = n; }
        VM_WAIT(); __syncthreads();
        kc = k1;
    }
    if (j < my_tiles) {
        const int k1 = kc == 2 ? 0 : kc + 1, k2 = k1 == 2 ? 0 : k1 + 1;
        ATT_DMA_K(j + 2, k2); ATT_DMA_V(j + 1, (j + 1) & 1);
        const LAS unsigned char* kb = lds + kc * A_KB; const LAS unsigned char* vb = lds + A_V0 + (j & 1) * A_VB;
        { f32x16 n; bf16x8 pa[2];
          attn_qk(n, kb, 1, q, n32, hi);
          const float alpha = attn_softmax(p, m_run, l_run, pa);
          ATT_SCHED();
          attn_pv(O, vb, pa, alpha, n32, hi);
          p = n; }
        { bf16x8 pa[2];
          const float alpha = attn_softmax(p, m_run, l_run, pa);
          attn_pv(O, vb + 64, pa, alpha, n32, hi); }
        VM_WAIT(); __syncthreads();
        kc = k1; ++j;
    }
    for (; j < ntiles; ++j) {
        const int k1 = kc == 2 ? 0 : kc + 1, k2 = k1 == 2 ? 0 : k1 + 1;
        ATT_DMA_K(j + 2, k2); ATT_DMA_V(j + 1, (j + 1) & 1);
        VM_WAIT(); __syncthreads();
        kc = k1;
    }
#undef ATT_DMA_K
#undef ATT_DMA_V
    __builtin_amdgcn_s_setprio(0);
    if (active) {
        const float il = 1.0f / l_run;
        unsigned char* orow = (unsigned char*)(OM + (size_t)(qrow0 + 32 * wid + n32) * DM + 2048 + h * 128) + (hi ? 16 : 0);
#pragma unroll
        for (int k = 0; k < 16; k += 2) { const int cb = k >> 2, g = k & 3;
            unsigned ax = pk2(O[cb][4 * g] * il, O[cb][4 * g + 1] * il), ay = pk2(O[cb][4 * g + 2] * il, O[cb][4 * g + 3] * il);
            unsigned bx = pk2(O[cb][4 * g + 4] * il, O[cb][4 * g + 5] * il), by = pk2(O[cb][4 * g + 6] * il, O[cb][4 * g + 7] * il);
            { auto r = __builtin_amdgcn_permlane32_swap(ax, bx, false, false); ax = r[0]; bx = r[1]; }
            { auto r = __builtin_amdgcn_permlane32_swap(ay, by, false, false); ay = r[0]; by = r[1]; }
            *(GAS v4u*)(orow + 16 * k) = (v4u){ax, ay, bx, by}; }
    }
}

constexpr int NWAVES = 8;
constexpr int N_PHASES = 15;
struct Args { const float* in[26]; float* out; unsigned char* ws; int ph_lo, ph_hi, li, pad1; };
__global__ void __launch_bounds__(NWAVES * 64, 2) mk_fwd(Args args) {
    extern __shared__ __attribute__((aligned(16))) unsigned char lds_raw[];
    LAS unsigned char* lds = (LAS unsigned char*)lds_raw;
    volatile LAS unsigned* MISC = (volatile LAS unsigned*)(lds + MISC_OFF);
    const int tid = threadIdx.x, lane = tid & 63, wave = __builtin_amdgcn_readfirstlane(tid >> 6);
    const int G = gridDim.x;
    const int gw = blockIdx.x * NWAVES + wave, NGW = G * NWAVES;
    unsigned char* ws = args.ws;
    unsigned* ctl = (unsigned*)(ws + WS_CTL);
    float* out = args.out;
    bf16* W1GU = (bf16*)(ws + WS_W1GU); bf16* W1D = (bf16*)(ws + WS_W1D); bf16* W2GU = (bf16*)(ws + WS_W2GU); bf16* W2D = (bf16*)(ws + WS_W2D);
    bf16* WIN = (bf16*)(ws + WS_WIN); bf16* WUQ = (bf16*)(ws + WS_WUQ); bf16* WUK = (bf16*)(ws + WS_WUK); bf16* WUV = (bf16*)(ws + WS_WUV); bf16* WOUT = (bf16*)(ws + WS_WOUT);
    bf16* XN = (bf16*)(ws + WS_XN); bf16* HID = (bf16*)(ws + WS_HID); bf16* Z = (bf16*)(ws + WS_Z); bf16* QAN = (bf16*)(ws + WS_QAN); bf16* QH = (bf16*)(ws + WS_QH);
    bf16* CALL = (bf16*)(ws + WS_CALL); bf16* KRA = (bf16*)(ws + WS_KR); bf16* KN = (bf16*)(ws + WS_KN); bf16* VT = (bf16*)(ws + WS_VT);
    float* slabs = (float*)(ws + WS_SLAB); bf16* HB = (bf16*)(ws + WS_HB);
    float* rcos = (float*)(ws + WS_TAB); float* rsin = rcos + 8192 * 128; float* mcos = rsin + 8192 * 128; float* msin = mcos + 8192 * 32;

    for (int u = tid; u < (LDS_BYTES - RING_BYTES) / 4; u += NWAVES * 64) ((LAS unsigned*)(lds + RING_BYTES))[u] = 0u;
    __syncthreads();
    volatile LAS unsigned* ARGP = (volatile LAS unsigned*)(lds + MISC_OFF + 256);
    if (tid < 26) { const unsigned long long pv = (unsigned long long)args.in[tid]; ARGP[2 * tid] = (unsigned)pv; ARGP[2 * tid + 1] = (unsigned)(pv >> 32); }
    __syncthreads();
#define ARGIN(k) ((const float*)(((unsigned long long)(unsigned)__builtin_amdgcn_readfirstlane((int)ARGP[2 * (k) + 1]) << 32) | (unsigned long long)(unsigned)__builtin_amdgcn_readfirstlane((int)ARGP[2 * (k)])))
    XcdBarrier bar = xcd_barrier_post(ctl + CW_BAR + args.li * XCD_BAR_WORDS, MISC + 8);
    const int lo = args.ph_lo, hi = args.ph_hi;
#ifndef MK_PHASE_MASK
#define MK_PHASE_MASK 0x7fff
#endif
#define IN(k) ((((MK_PHASE_MASK) >> (k)) & 1) && lo <= (k) && (k) < hi)
#define NEXTP(k) ((k) == 6 ? 8 : (k) + 1)
#define SEAM(k) do { if (IN(k) && IN(NEXTP(k))) xcd_barrier(bar); } while (0)

    constexpr int BGQ_B0 = (DM / 64) * (DIN / 32), BGQ_B1 = BGQ_B0 + 16 * 96, BGQ_B2 = BGQ_B1 + 8 * 128, BGQ_B3 = BGQ_B2 + 64 * 128, BGQ_B4 = BGQ_B3 + 64 * (DFF / 32), BGQ_B5 = BGQ_B4 + 64 * (DFF / 32), BGQ_B6 = BGQ_B5 + (DFF / 64) * 128, BGQ_B7 = BGQ_B6 + (DFF / 64) * 128;
    static_assert(BGQ_B0 % 64 == 0 && BGQ_B1 % 64 == 0 && BGQ_B2 % 64 == 0 && BGQ_B3 % 64 == 0 && BGQ_B4 % 64 == 0 && BGQ_B5 % 64 == 0 && BGQ_B6 % 64 == 0 && BGQ_B7 % 64 == 0, "a chunk of 64 items never straddles two matrices");
#define BG_DRAIN(ctr_, it_lo_, it_hi_) do { \
        for (;;) { \
            if (tid == 0) MISC[0] = __hip_atomic_fetch_add((ctr_), 1u, __ATOMIC_RELAXED, __HIP_MEMORY_SCOPE_AGENT); \
            __syncthreads(); \
            const int ch_ = (int)__builtin_amdgcn_readfirstlane(MISC[0]); \
            __syncthreads(); \
            const int it0 = (it_lo_) + ch_ * 64; if (it0 >= (it_hi_)) break; \
            _Pragma("unroll 1") \
            for (int q = 0; q < 8; q += 4) { const int it = it0 + wave * 8 + q; \
                if (it0 < BGQ_B0) convert_items4(ARGIN(10), DM, DIN, 0, WIN, nullptr, scr, it, lane); \
                else if (it0 < BGQ_B1) convert_items4(ARGIN(13), 1024, 3072, 0, WUQ, nullptr, scr, it - BGQ_B0, lane); \
                else if (it0 < BGQ_B2) convert_items4(ARGIN(18), 512, 4096, 3, WUK, WUV, scr, it - BGQ_B1, lane); \
                else if (it0 < BGQ_B3) convert_items4(ARGIN(20), DM, DM, 0, WOUT, nullptr, scr, it - BGQ_B2, lane); \
                else if (it0 < BGQ_B4) convert_items4(ARGIN(22), DM, DFF, 1, W2GU, nullptr, scr, it - BGQ_B3, lane); \
                else if (it0 < BGQ_B5) convert_items4(ARGIN(23), DM, DFF, 2, W2GU, nullptr, scr, it - BGQ_B4, lane); \
                else if (it0 < BGQ_B6) convert_items4(ARGIN(24), DFF, DM, 0, W2D, nullptr, scr, it - BGQ_B5, lane); \
                else convert_items4(ARGIN(8), DFF, DM, 0, W1D, nullptr, scr, it - BGQ_B6, lane); } \
        } } while (0)

#define P0_MISC(gt, NGT) do { const float* x_p = ARGIN(0); const float* x_s = ARGIN(1); \
        for (int i = gt; i < (ZLD - DIN) * DM / 8; i += NGT) ((GAS v4u*)(WIN + (size_t)DIN * DM))[i] = (v4u){0u, 0u, 0u, 0u}; \
        for (int i = gt; i < 8192 * 128; i += NGT) { float c, s; sincos_tab(i >> 7, i & 127, 128, c, s); rcos[i] = c; rsin[i] = s; } \
        for (int i = gt; i < 8192 * 32; i += NGT) { float c, s; sincos_tab(i >> 5, i & 31, 32, c, s); mcos[i] = c; msin[i] = s; } \
        for (int i = gt; i < 8 * 1024 * 512 / 8; i += NGT) { const int e = i * 8, sb = e / (1024 * 512), rem = e - sb * 1024 * 512, p = rem >> 9, c = rem & 511; \
            const f32x4 a = *(const GAS f32x4*)(ARGIN(3) + e), b = *(const GAS f32x4*)(ARGIN(3) + e + 4); \
            v4u w; w.x = pk2(a.x, a.y); w.y = pk2(a.z, a.w); w.z = pk2(b.x, b.y); w.w = pk2(b.z, b.w); \
            *(GAS v4u*)(CALL + (size_t)(TP + 1088 * sb + p) * 512 + c) = w; } \
        for (int i = gt; i < 8 * 1024 * 64 / 8; i += NGT) { const int e = i * 8, sb = e / (1024 * 64), rem = e - sb * 1024 * 64, p = rem >> 6, c = rem & 63; \
            const f32x4 a = *(const GAS f32x4*)(ARGIN(4) + e), b = *(const GAS f32x4*)(ARGIN(4) + e + 4); \
            v4u w; w.x = pk2(a.x, a.y); w.y = pk2(a.z, a.w); w.z = pk2(b.x, b.y); w.w = pk2(b.z, b.w); \
            *(GAS v4u*)(KRA + (size_t)(TP + 1088 * sb + p) * 64 + c) = w; } \
        {  \
            pg8::SplitTailOrder S; S.init(TT, DM, G, 0, DFF); S.wgm = MK_WGM_DOWN; const int R = S.nwg / G, rem = S.nwg - R * G; \
            for (int e = gt; e < rem * 16384; e += NGT) { const int tl = e >> 14, w = e & 16383, row = w >> 6, c4 = w & 63; pg8::Unit u; S.tile(R * G + tl, u); \
                const int r = u.pm * 256 + row; const float* src = (r < TP ? x_p + (size_t)r * DM : x_s + (size_t)(r - TP) * DM) + u.pn * 256 + 4 * c4; \
                const f32x4 xv = *(const GAS f32x4*)src; v2u hw; hw.x = pk2(xv.x, xv.y); hw.y = pk2(xv.z, xv.w); *(GAS v2u*)(HB + (size_t)r * DM + u.pn * 256 + 4 * c4) = hw; } } \
    } while (0)
    if (IN(0)) {
        const float* x_p = ARGIN(0); const float* x_s = ARGIN(1);
        LAS float* scr = (LAS float*)(lds + wave * 16384);
        convert_weight(ARGIN(6), DM, DFF, 1, W1GU, nullptr, scr, gw, NGW, lane);
        convert_weight(ARGIN(7), DM, DFF, 2, W1GU, nullptr, scr, gw, NGW, lane);
        if (G <= 248) { const int gt = blockIdx.x * (NWAVES * 64) + tid, NGT = G * NWAVES * 64; P0_MISC(gt, NGT); }
        norm_phase<false, true>(x_p, x_s, ARGIN(5), XN, nullptr, gw, NGW, lane, nullptr, nullptr, 0.f);
    }
    SEAM(0);
    if (IN(1)) {
        constexpr int GG = 248;
        const bool bg_only = G > GG && (int)blockIdx.x >= GG;
        if (!bg_only) { pg8::Gemm g{XN, W1GU, TT, 2 * DFF, DM}; pg8::StaticOrder S; S.init(TT, 2 * DFF, G > GG ? GG : G, (int)blockIdx.x, DM); pg8::EpiSwiGLU E{HID, DFF};
            pg8::gemm_phase<pg8::EpiSwiGLU, pg8::StaticOrder, true, true>(lds, g, S, E); }
        LAS float* scr = (LAS float*)(lds + wave * 16384);
        if (bg_only) { const int gt = ((int)blockIdx.x - GG) * (NWAVES * 64) + tid, NGT = (G - GG) * NWAVES * 64; P0_MISC(gt, NGT); }
        BG_DRAIN(ctl + CW_BGQ + 256 + 64 * args.li, BGQ_B6, BGQ_B7);
        BG_DRAIN(ctl + CW_BGQ + 64 * args.li, 0, (G == 256) ? BGQ_B2 : BGQ_B6);
    }
    SEAM(1);
    if (IN(2)) { pg8::Gemm g{HID, W1D, TT, DM, DFF}; pg8::SplitTailOrder S; S.init(TT, DM, G, (int)blockIdx.x, DFF); S.wgm = MK_WGM_DOWN; pg8::EpiResid<false> E{ARGIN(0), ARGIN(1), TP / 256, HB, DM, 0.5f, DFF / 64, slabs};
        pg8::gemm_phase<pg8::EpiResid<false>, pg8::SplitTailOrder, true, true>(lds, g, S, E); }
    SEAM(2);
    if (IN(3)) { LAS unsigned char* tab = lds; build_split_tab(tab, G, DFF, tid, MK_WGM_DOWN);
        norm_phase_h<true>(HB, ARGIN(9), XN, nullptr, gw, NGW, lane, tab, slabs, 0.5f, 8); }
    SEAM(3);
    if (IN(4)) { pg8::Gemm g{XN, WIN, TT, ZLD, DM}; pg8::WinOrder S; S.init(TT, ZLD, G, (int)blockIdx.x, DM); S.r0 = 0; S.r1 = (G == 256) ? 10 : (1 << 20); pg8::EpiZ E{Z, ZLD, rcos, rsin};
        pg8::gemm_phase<pg8::EpiZ, pg8::WinOrder, true, true>(lds, g, S, E); }
    SEAM(4);
    if (IN(5)) {
        const float* gqa = ARGIN(12); const float* gkva = ARGIN(16);
        const f32x4 gq0 = *(const GAS f32x4*)(gqa + 8 * lane), gq1 = *(const GAS f32x4*)(gqa + 8 * lane + 4), gq2 = *(const GAS f32x4*)(gqa + 512 + 8 * lane), gq3 = *(const GAS f32x4*)(gqa + 512 + 8 * lane + 4);
        const f32x4 gk0 = *(const GAS f32x4*)(gkva + 8 * lane), gk1 = *(const GAS f32x4*)(gkva + 8 * lane + 4);
        const float gkr = ARGIN(17)[lane];
        v4u nqa, nqb, nkv; unsigned nkr = 0u; float ncs = 0.f, nsn = 0.f;
#define P5_LOAD(rr) do { const bf16* zr_ = Z + (size_t)(rr) * ZLD + 8192; nqa = *(const GAS v4u*)(zr_ + 8 * lane); nqb = *(const GAS v4u*)(zr_ + 512 + 8 * lane); nkv = *(const GAS v4u*)(zr_ + 1024 + 8 * lane); nkr = (unsigned)zr_[1536 + lane]; \
        const int pp_ = pos_of_row(rr); ncs = mcos[pp_ * 32 + (lane & 31)]; nsn = msin[pp_ * 32 + (lane & 31)]; } while (0)
        if (gw < TT) P5_LOAD(gw);
        for (int r = gw; r < TT; r += NGW) {
            const v4u qa = nqa, qb = nqb, kv = nkv; const float kr = bflo(nkr), c = ncs, sn = nsn;
            if (r + NGW < TT) P5_LOAD(r + NGW);
            float q[16], c8[8];
            q[0] = bflo(qa.x); q[1] = bfhi(qa.x); q[2] = bflo(qa.y); q[3] = bfhi(qa.y); q[4] = bflo(qa.z); q[5] = bfhi(qa.z); q[6] = bflo(qa.w); q[7] = bfhi(qa.w);
            q[8] = bflo(qb.x); q[9] = bfhi(qb.x); q[10] = bflo(qb.y); q[11] = bfhi(qb.y); q[12] = bflo(qb.z); q[13] = bfhi(qb.z); q[14] = bflo(qb.w); q[15] = bfhi(qb.w);
            c8[0] = bflo(kv.x); c8[1] = bfhi(kv.x); c8[2] = bflo(kv.y); c8[3] = bfhi(kv.y); c8[4] = bflo(kv.z); c8[5] = bfhi(kv.z); c8[6] = bflo(kv.w); c8[7] = bfhi(kv.w);
            float sq = 0.f, sc = 0.f;
#pragma unroll
            for (int i = 0; i < 16; ++i) sq += q[i] * q[i];
#pragma unroll
            for (int i = 0; i < 8; ++i) sc += c8[i] * c8[i];
            const float rq = 1.0f / sqrtf(wave_sum(sq) * (1.0f / 1024.0f) + EPSN), rc = 1.0f / sqrtf(wave_sum(sc) * (1.0f / 512.0f) + EPSN), rk = 1.0f / sqrtf(wave_sum(kr * kr) * (1.0f / 64.0f) + EPSN);
            { v4u w;
              w.x = pk2(q[0] * rq * gq0.x, q[1] * rq * gq0.y); w.y = pk2(q[2] * rq * gq0.z, q[3] * rq * gq0.w); w.z = pk2(q[4] * rq * gq1.x, q[5] * rq * gq1.y); w.w = pk2(q[6] * rq * gq1.z, q[7] * rq * gq1.w);
              *(GAS v4u*)(QAN + (size_t)r * 1024 + 8 * lane) = w;
              w.x = pk2(q[8] * rq * gq2.x, q[9] * rq * gq2.y); w.y = pk2(q[10] * rq * gq2.z, q[11] * rq * gq2.w); w.z = pk2(q[12] * rq * gq3.x, q[13] * rq * gq3.y); w.w = pk2(q[14] * rq * gq3.z, q[15] * rq * gq3.w);
              *(GAS v4u*)(QAN + (size_t)r * 1024 + 512 + 8 * lane) = w; }
            const int cr = crow_of_row(r);
            float* ock = r < TP ? out + O_CKP + (size_t)r * 512 : out + O_CKS + (size_t)(r - TP) * 512;
            float* okr = r < TP ? out + O_KRP + (size_t)r * 64 : out + O_KRS + (size_t)(r - TP) * 64;
            { const f32x4 o0 = (f32x4){c8[0] * rc * gk0.x, c8[1] * rc * gk0.y, c8[2] * rc * gk0.z, c8[3] * rc * gk0.w}, o1 = (f32x4){c8[4] * rc * gk1.x, c8[5] * rc * gk1.y, c8[6] * rc * gk1.z, c8[7] * rc * gk1.w};
              *(GAS f32x4*)(ock + 8 * lane) = o0; *(GAS f32x4*)(ock + 8 * lane + 4) = o1;
              v4u w; w.x = pk2(o0.x, o0.y); w.y = pk2(o0.z, o0.w); w.z = pk2(o1.x, o1.y); w.w = pk2(o1.z, o1.w);
              *(GAS v4u*)(CALL + (size_t)cr * 512 + 8 * lane) = w; }
            { const float y = kr * rk * gkr; const float yp = __shfl_xor(y, 32);
              const float o = lane < 32 ? y * c - yp * sn : y * c + yp * sn;
              okr[lane] = o; KRA[(size_t)cr * 64 + lane] = (bf16)f2bf(o); }
        }
#undef P5_LOAD
    }
    SEAM(5);
    if (IN(6)) {
        const int c = (int)blockIdx.x; const bool part = (G == 256);
        if (!part || c < 120) { pg8::Gemm g{QAN, WUQ, TT, QLD, 1024}; pg8::StaticOrder S; S.init(TT, QLD, part ? 120 : G, c, 1024); pg8::EpiBf16P E{QH, QLD};
          pg8::gemm_phase<pg8::EpiBf16P, pg8::StaticOrder, true, true>(lds, g, S, E); }
        if (!part || (c >= 120 && c < 181)) { pg8::Gemm g{CALL, WUK, KROWS, KNLD, 512}; pg8::StaticOrder S; S.init(KROWS, KNLD, part ? 61 : G, part ? c - 120 : c, 512); pg8::EpiKNorm E{KN, KNLD, ARGIN(19), (LAS float*)(lds + RING_BYTES + 4096)};
          pg8::gemm_phase<pg8::EpiKNorm, pg8::StaticOrder, true, true>(lds, g, S, E); }
        if (!part || (c >= 181 && c < 242)) { pg8::Gemm g{WUV, CALL, 2048, KROWS, 512}; pg8::StaticOrder S; S.init(2048, KROWS, part ? 61 : G, part ? c - 181 : c, 512); pg8::EpiBf16P E{VT, KROWS};
          pg8::gemm_phase<pg8::EpiBf16P, pg8::StaticOrder, true, true>(lds, g, S, E); }
        if (part && c >= 242) { pg8::Gemm g{XN, WIN, TT, ZLD, DM}; pg8::WinOrder S; S.init(TT, ZLD, 256, c - 242, DM); S.r0 = 10; S.r1 = 11; pg8::EpiZ E{Z, ZLD, rcos, rsin};
          pg8::gemm_phase<pg8::EpiZ, pg8::WinOrder, true, true>(lds, g, S, E); }
    }
    SEAM(6);
    if (IN(8)) {
        constexpr int NQ_RP = 4, NQ_AP = 128, NQ_AS = 16, NQ_RS = 16, NQ = NQ_RP + NQ_AP + NQ_AS + NQ_RS;
        const int myx = (int)(xb_xcc_id() & 7u);
        if (G == 256 && (int)blockIdx.x >= 232) {
            LAS float* scr = (LAS float*)(lds + wave * 16384);
            BG_DRAIN(ctl + CW_BGQ + 128 + 64 * args.li, BGQ_B2, BGQ_B6);
            __syncthreads();
        }
        int qoff = 0;
        for (;;) {
            const int qx = (myx + qoff) & 7;
            if (tid == 0) MISC[0] = __hip_atomic_fetch_add(ctl + CW_QUEUE + 64 * (8 * args.li + qx), 1u, __ATOMIC_RELAXED, __HIP_MEMORY_SCOPE_AGENT);
            __syncthreads();
            const int li_ = (int)__builtin_amdgcn_readfirstlane(MISC[0]);
            __syncthreads();
            if (li_ >= NQ) { if (++qoff == 8) break; continue; }
            int kind, p0, p1, p2;
            bool is_ret;
            if (li_ < NQ_RP) { const int idx = qx * NQ_RP + li_; is_ret = true; kind = 0; p0 = idx >> 4; p1 = (idx >> 1) & 7; p2 = idx & 1; }
            else if (li_ < NQ_RP + NQ_AP + NQ_AS) {
                const int ua = li_ - NQ_RP;
                if (ua >= 112 && ua < 112 + NQ_AS) { const int u = qx * NQ_AS + (ua - 112); is_ret = false; kind = 1; p0 = 0; p1 = u >> 4; p2 = u & 15; }
                else { const int u = ua < 112 ? ua : ua - NQ_AS, bh = 4 * qx + (u & 3); is_ret = false; kind = 0; p0 = 31 - (u >> 2); p1 = bh >> 4; p2 = bh & 15; } }
            else { const int u = qx * NQ_RS + (li_ - NQ_RP - NQ_AP - NQ_AS); is_ret = true; kind = 1; p0 = u >> 4; p1 = (u >> 1) & 7; p2 = u & 1; }
            int tid2 = tid; asm volatile("" : "+v"(tid2));
            if (is_ret) {
#ifndef MK_NO_RET
                float* so = kind == 0 ? out + O_SRP + (size_t)(p0 * 8 + p1) * 65536 : out + O_SRS + (size_t)(p0 * 8 + p1) * 65536;
                ret_unit(lds, kind, p0, p1, p2, Z, XN, ARGIN(2), so, tid2);
#ifdef MK_RET2
                if (kind == 0) { asm volatile("" : "+v"(tid2)); ret_unit(lds, kind, p0, p1, p2, Z, XN, ARGIN(2), so, tid2); }
#endif
#endif
            } else {
#ifndef MK_NO_ATT
                const int qrow0 = kind == 0 ? p1 * SEQ + 256 * p0 : TP + 64 * p1, krow0 = kind == 0 ? p1 * SEQ : TP + 1088 * p1;
                attn_unit(lds, qrow0, kind == 0 ? 8 : 2, krow0, kind == 0 ? 4 * p0 + 4 : 17, kind == 0 ? 4 * p0 : -1, p2, QH, KN, KRA, VT, XN, tid2, ARGIN(14), ARGIN(15), mcos, msin);
#endif
            }
        }
    }
    SEAM(8);
    if (IN(9)) {
#define P9_DPP(x, ctrl) __builtin_bit_cast(float, __builtin_amdgcn_update_dpp(0, __builtin_bit_cast(int, (float)(x)), (ctrl), 0xF, 0xF, false))
#define P9_SUM32(v) do { v += P9_DPP(v, 0xB1); v += P9_DPP(v, 0x4E); v += P9_DPP(v, 0x141); v += P9_DPP(v, 0x140); v += __shfl_xor(v, 16); } while (0)
        v4u pn[4], pg[4];
        f32x4 gg[8];
        { const float* gp = ARGIN(11);
#pragma unroll
          for (int k = 0; k < 4; ++k) { gg[2 * k] = *(const GAS f32x4*)(gp + 512 * k + 8 * lane); gg[2 * k + 1] = *(const GAS f32x4*)(gp + 512 * k + 8 * lane + 4); } }
#define P9_LOAD(rr) do { const bf16* b_ = XN + (size_t)(rr) * DM + 8 * lane; const bf16* g_ = Z + (size_t)(rr) * ZLD + 6144 + 8 * lane; \
            _Pragma("unroll") for (int k = 0; k < 4; ++k) { pn[k] = *(const GAS v4u*)(b_ + 512 * k); pg[k] = *(const GAS v4u*)(g_ + 512 * k); } } while (0)
        if (gw < TT) P9_LOAD(gw);
        for (int r = gw; r < TT; r += NGW) {
            bf16* base = XN + (size_t)r * DM + 8 * lane;
            v4u nv[4], gv[4];
#pragma unroll
            for (int k = 0; k < 4; ++k) { nv[k] = pn[k]; gv[k] = pg[k]; }
            if (r + NGW < TT) P9_LOAD(r + NGW);
#pragma unroll
            for (int k = 0; k < 4; ++k) { float x[8], gt[8];
                x[0] = bflo(nv[k].x); x[1] = bfhi(nv[k].x); x[2] = bflo(nv[k].y); x[3] = bfhi(nv[k].y); x[4] = bflo(nv[k].z); x[5] = bfhi(nv[k].z); x[6] = bflo(nv[k].w); x[7] = bfhi(nv[k].w);
                gt[0] = bflo(gv[k].x); gt[1] = bfhi(gv[k].x); gt[2] = bflo(gv[k].y); gt[3] = bfhi(gv[k].y); gt[4] = bflo(gv[k].z); gt[5] = bfhi(gv[k].z); gt[6] = bflo(gv[k].w); gt[7] = bfhi(gv[k].w);
                float sm = ((x[0] + x[1]) + (x[2] + x[3])) + ((x[4] + x[5]) + (x[6] + x[7]));
                P9_SUM32(sm);
                const float mu = sm * (1.0f / 256.0f); float sv = 0.f;
#pragma unroll
                for (int i = 0; i < 8; ++i) { x[i] -= mu; sv += x[i] * x[i]; }
                P9_SUM32(sv);
                const float rs = 1.0f / sqrtf(sv * (1.0f / 256.0f) + EPSN);
                float o[8];
#pragma unroll
                for (int i = 0; i < 8; ++i) o[i] = x[i] * rs * gg[2 * k + (i >> 2)][i & 3] * pg8::fast_silu(gt[i]);
                v4u w; w.x = pk2(o[0], o[1]); w.y = pk2(o[2], o[3]); w.z = pk2(o[4], o[5]); w.w = pk2(o[6], o[7]); *(GAS v4u*)(base + 512 * k) = w; }
        }
#undef P9_LOAD
#undef P9_SUM32
#undef P9_DPP
    }
    SEAM(9);
    if (IN(10)) { pg8::Gemm g{XN, WOUT, TT, DM, DM}; pg8::SplitTailOrder S; S.init(TT, DM, G, (int)blockIdx.x, DM); pg8::EpiResid<true> E{nullptr, nullptr, 1 << 20, HB, DM, 1.0f, DM / 64, slabs};
        pg8::gemm_phase<pg8::EpiResid<true>, pg8::SplitTailOrder, true, true>(lds, g, S, E); }
    SEAM(10);
    if (IN(11)) { LAS unsigned char* tab = lds; build_split_tab(tab, G, DM, tid, 8);
        norm_phase_h<true>(HB, ARGIN(21), XN, nullptr, gw, NGW, lane, tab, slabs, 1.0f, 8); }
    SEAM(11);
    if (IN(12)) { pg8::Gemm g{XN, W2GU, TT, 2 * DFF, DM}; pg8::StaticOrder S; S.init(TT, 2 * DFF, G, (int)blockIdx.x, DM); pg8::EpiSwiGLU E{HID, DFF};
        pg8::gemm_phase<pg8::EpiSwiGLU, pg8::StaticOrder, true, true>(lds, g, S, E); }
    SEAM(12);
    if (IN(13)) { pg8::Gemm g{HID, W2D, TT, DM, DFF}; pg8::SplitTailOrder S; S.init(TT, DM, G, (int)blockIdx.x, DFF); S.wgm = MK_WGM_DOWN; pg8::EpiResid<true> E{nullptr, nullptr, 1 << 20, HB, DM, 0.5f, DFF / 64, slabs};
        pg8::gemm_phase<pg8::EpiResid<true>, pg8::SplitTailOrder, true, true>(lds, g, S, E); }
    SEAM(13);
    if (IN(14)) { LAS unsigned char* tab = lds; build_split_tab(tab, G, DFF, tid, MK_WGM_DOWN);
        norm_phase_y(HB, ARGIN(25), out, gw, NGW, lane, tab, slabs, 0.5f, 8); }
#ifdef MK_PROBE_SUMS
    if (lo <= 14 && 14 < hi) {
        const int gt = blockIdx.x * (NWAVES * 64) + tid, NGT = G * NWAVES * 64;
        for (size_t i = gt; i < (size_t)TT * DM; i += NGT) if (i >= 65536) out[i] = 0.f;
        for (int r = gw; r < TT + KROWS + 2048; r += NGW) {
            const bf16* src; int n;
            if (r < TT) { src = QH + (size_t)r * QLD; n = QLD; } else if (r < TT + KROWS) { src = KN + (size_t)(r - TT) * KNLD; n = KNLD; } else { src = VT + (size_t)(r - TT - KROWS) * KROWS; n = KROWS; }
            float s = 0.f;
            for (int i = lane; i < n; i += 64) s += bflo((unsigned)src[i]) * (float)(1 + (i & 7));
            s = wave_sum(s);
            if (lane == 0) out[r] = s;
        }
    }
#endif
#ifdef MK_NO_RET
    if (lo <= 14 && 14 < hi) {
#else
    if (!((MK_PHASE_MASK >> 8) & 1) && lo <= 14 && 14 < hi) {
#endif
        const int gt = blockIdx.x * (NWAVES * 64) + tid, NGT = G * NWAVES * 64;
        for (int i = gt; i < 1048576; i += NGT) out[O_SRP + i] = 0.f;
        for (int i = gt; i < 4194304; i += NGT) out[O_SRS + i] = 0.f;
    }
#undef IN
#undef SEAM
}

#ifndef MK_CUT
#define MK_CUT 0
#endif
extern "C" void kernel_launch(void* const* d_in, const int* in_sizes, int n_in, void* d_out, int out_size, void* d_ws, size_t ws_size, hipStream_t stream) {
    static int grid = 0;
    if (grid == 0) {
        if (n_in != 26 || (size_t)out_size != O_END || ws_size < WS_END) { fprintf(stderr, "kernel_launch: unexpected problem (n_in %d, out %d, ws %zu < %zu); nothing launched\n", n_in, out_size, ws_size, (size_t)WS_END); grid = -1; return; }
        int dev = 0, cus = 0, per_cu = 0;
        if (hipGetDevice(&dev) != hipSuccess || hipDeviceGetAttribute(&cus, hipDeviceAttributeMultiprocessorCount, dev) != hipSuccess) { grid = -1; return; }
        if (hipFuncSetAttribute((const void*)mk_fwd, hipFuncAttributeMaxDynamicSharedMemorySize, LDS_BYTES) != hipSuccess) { fprintf(stderr, "kernel_launch: hipFuncSetAttribute failed\n"); grid = -1; return; }
        if (hipOccupancyMaxActiveBlocksPerMultiprocessor(&per_cu, (const void*)mk_fwd, NWAVES * 64, LDS_BYTES) != hipSuccess || per_cu < 1) { fprintf(stderr, "kernel_launch: occupancy query says %d blocks per CU\n", per_cu); }
        (void)hipGetLastError();
        grid = cus;
    }
    if (grid < 0) return;
    (void)hipMemsetAsync((char*)d_ws + WS_CTL, 0, CTL_ZERO_BYTES, stream);
    Args a{};
    for (int i = 0; i < 26; ++i) a.in[i] = (const float*)d_in[i];
    a.out = (float*)d_out; a.ws = (unsigned char*)d_ws; a.li = 0; a.pad1 = 0;
#if MK_CUT
    for (int p = 0; p < N_PHASES; ++p) { a.ph_lo = p; a.ph_hi = p + 1; hipLaunchKernelGGL(mk_fwd, dim3(grid), dim3(NWAVES * 64), LDS_BYTES, stream, a); }
#elif defined(MK_DUP_LO)
    a.ph_lo = 0; a.ph_hi = MK_DUP_HI; a.li = 0;
    hipLaunchKernelGGL(mk_fwd, dim3(grid), dim3(NWAVES * 64), LDS_BYTES, stream, a);
    a.ph_lo = MK_DUP_LO; a.ph_hi = N_PHASES; a.li = 1;
    hipLaunchKernelGGL(mk_fwd, dim3(grid), dim3(NWAVES * 64), LDS_BYTES, stream, a);
#else
    a.ph_lo = 0; a.ph_hi = N_PHASES;
    hipLaunchKernelGGL(mk_fwd, dim3(grid), dim3(NWAVES * 64), LDS_BYTES, stream, a);
#endif
}
```

```cpp
#include <hip/hip_runtime.h>
#include <cstdio>
#include <cstdint>
namespace pg8 {
#define PG8_LAS __attribute__((address_space(3)))
typedef unsigned short bf16_t;
typedef short bf16x8 __attribute__((ext_vector_type(8)));
typedef float f32x4 __attribute__((ext_vector_type(4)));
typedef unsigned u32x4 __attribute__((ext_vector_type(4)));
constexpr int BM = 256, BK = 64, HALF = 128, HTB = HALF * BK * 2  , STAGE_BYTES = 8 * HTB, NXCD = 8, WGM = 8;

__host__ __device__ __forceinline__ int lds_byte(int r, int c) { const int st = (r >> 4) * 2 + (c >> 5), rr = r & 15, cc = c & 31, ob = rr * 64 + cc * 2; return st * 1024 + (ob ^ (((ob >> 9) & 1) << 5)); }
__host__ __device__ __forceinline__ void stage_rc(int b, int& R, int& C) { const int st = b / 1024, sb = b % 1024, swz = sb ^ (((sb >> 9) & 1) << 5); R = (st >> 1) * 16 + swz / 64; C = (st & 1) * 32 + (swz % 64) / 2; }
__host__ __device__ __forceinline__ int perm32(int rho) { const int n = rho >> 4, i = rho & 15; return 8 * (i >> 2) + 4 * n + (i & 3); }

struct Unit { int pm, pn, kt0, nt; };
struct Gemm { const bf16_t* A; const bf16_t* Bt; int M, N, K; };

struct StaticOrder {
    int nM, nN, nwg, G, c, ntk, wgm;
    __host__ __device__ __forceinline__ void init(int M, int N, int G_, int c_, int K) { nM = M / BM; nN = N / BM; nwg = nM * nN; G = G_; c = c_; ntk = K / BK; wgm = WGM; }
    __host__ __device__ __forceinline__ void tile(int L, Unit& u) const {
        int wgid = L; { const int q = nwg / NXCD, r = nwg % NXCD, xcd = wgid % NXCD, off = wgid / NXCD; wgid = (xcd < r ? xcd * (q + 1) : r * (q + 1) + (xcd - r) * q) + off; }
        const int nig = wgm * nN, gid = wgid / nig, fm = gid * wgm, gsz = (nM - fm) < wgm ? (nM - fm) : wgm;
        u.pm = fm + ((wgid % nig) % gsz); u.pn = (wgid % nig) / gsz;
    }
    __host__ __device__ __forceinline__ bool next(int i, Unit& u) const {
        const long L = (long)i * G + c; if (L >= nwg) return false;
        tile((int)L, u); u.kt0 = 0; u.nt = ntk; return true;
    }
    __device__ __forceinline__ void a_ready(const Unit&) const {}
    __device__ __forceinline__ void done(const Unit&) const {}
};
struct SplitTailOrder : StaticOrder {
    __host__ __device__ __forceinline__ bool next(int i, Unit& u) const {
        const int R = nwg / G, rem = nwg - R * G;
        if (i < R) { tile(i * G + c, u); u.kt0 = 0; u.nt = ntk; return true; }
        if (i > R || rem == 0) return false;
        const int S = G / rem, t = c / S, p = c - t * S; if (t >= rem) return false;
        tile(R * G + t, u);
        const int pairs = ntk / 2, q = pairs / S, r = pairs - q * S;
        u.kt0 = 2 * (p * q + (p < r ? p : r)); u.nt = 2 * (q + (p < r ? 1 : 0)); return true;
    }
};
struct WinOrder : StaticOrder {
    int r0, r1;
    __host__ __device__ __forceinline__ bool next(int i, Unit& u) const {
        const int r = i + r0; const long L = (long)r * G + c; if (r >= r1 || L >= nwg) return false;
        tile((int)L, u); u.pn += 10; if (u.pn >= nN) u.pn -= nN; u.kt0 = 0; u.nt = ntk; return true;
    }
};
typedef float f32x2_t __attribute__((ext_vector_type(2))); typedef __bf16 bf16x2_t __attribute__((ext_vector_type(2)));
__device__ __forceinline__ unsigned cvt_pk_bf16(float lo, float hi) { f32x2_t v = {lo, hi}; bf16x2_t b = __builtin_convertvector(v, bf16x2_t); return __builtin_bit_cast(unsigned, b); }
typedef float f32x2 __attribute__((ext_vector_type(2)));
__device__ __forceinline__ float fast_silu(float g) { return g * __builtin_amdgcn_rcpf(1.0f + __builtin_amdgcn_exp2f(-1.4426950408889634f * g)); }
struct EpiSwiGLU {
    static constexpr bool PERM = true, AFTER_DRAIN = false;
    bf16_t* H; int ldh;
    __device__ __forceinline__ void operator()(const f32x4 (&acc)[2][2][4][2], const Unit& u, int wr, int wc, int fr, int fq) const {
        const int row0 = u.pm * BM + wr * 64 + fr, col0 = u.pn * HALF + wc * 32 + 8 * fq;
#pragma unroll
        for (int ai = 0; ai < 2; ++ai)
#pragma unroll
            for (int m = 0; m < 4; ++m) { bf16_t* rowp = H + (size_t)(row0 + ai * HALF + m * 16) * ldh + col0;
                const f32x4 g0 = acc[ai][0][m][0], g1 = acc[ai][0][m][1], u0 = acc[ai][1][m][0], u1 = acc[ai][1][m][1];
                f32x4 v0, v1;
#pragma unroll
                for (int j = 0; j < 4; ++j) { v0[j] = fast_silu(g0[j]) * u0[j]; v1[j] = fast_silu(g1[j]) * u1[j]; }
                u32x4 w; w.x = cvt_pk_bf16(v0[0], v0[1]); w.y = cvt_pk_bf16(v0[2], v0[3]); w.z = cvt_pk_bf16(v1[0], v1[1]); w.w = cvt_pk_bf16(v1[2], v1[3]);
                *(u32x4*)rowp = w; }
    }
};
template <bool BASE_BF16> struct EpiResid {
    static constexpr bool PERM = true, AFTER_DRAIN = false;
    const float* base0; const float* base1; int split_pm; bf16_t* hout; int ldc; float alpha; int ntk_full; float* slabs;
    __device__ __forceinline__ void operator()(const f32x4 (&acc)[2][2][4][2], const Unit& u, int wr, int wc, int fr, int fq) const {
        const int row0 = u.pm * BM + wr * 64 + fr, col0 = u.pn * BM + wc * 32 + 8 * fq;
        if (u.nt != ntk_full) {
            bf16_t* sp = (bf16_t*)slabs + (size_t)blockIdx.x * 65536 + (size_t)(wr * 64 + fr) * 256 + wc * 32 + 8 * fq;
#pragma unroll
            for (int ai = 0; ai < 2; ++ai)
#pragma unroll
                for (int m = 0; m < 4; ++m) {
#pragma unroll
                    for (int bj = 0; bj < 2; ++bj) { const f32x4 a0 = acc[ai][bj][m][0], a1 = acc[ai][bj][m][1];
                        u32x4 w; w.x = cvt_pk_bf16(a0[0], a0[1]); w.y = cvt_pk_bf16(a0[2], a0[3]); w.z = cvt_pk_bf16(a1[0], a1[1]); w.w = cvt_pk_bf16(a1[2], a1[3]); *(u32x4*)(sp + bj * HALF) = w; }
                    sp += (m == 3 ? (HALF - 48) : 16) * 256; asm volatile("" : "+v"(sp)); }
            return;
        }
        const float* bb = (u.pm >= split_pm) ? base1 - (size_t)split_pm * BM * ldc : base0;
        if constexpr (BASE_BF16) {
            u32x4 bw[2][4][2];
#pragma unroll
            for (int ai = 0; ai < 2; ++ai)
#pragma unroll
                for (int m = 0; m < 4; ++m) { const size_t off = (size_t)(row0 + ai * HALF + m * 16) * ldc + col0;
#pragma unroll
                    for (int bj = 0; bj < 2; ++bj) bw[ai][m][bj] = *(const u32x4*)(hout + off + bj * HALF); }
#pragma unroll
            for (int ai = 0; ai < 2; ++ai)
#pragma unroll
                for (int m = 0; m < 4; ++m) { const size_t off = (size_t)(row0 + ai * HALF + m * 16) * ldc + col0;
#pragma unroll
                    for (int bj = 0; bj < 2; ++bj) { const u32x4 b4 = bw[ai][m][bj];
                        const f32x4 b0 = (f32x4){__builtin_bit_cast(float, b4.x << 16), __builtin_bit_cast(float, b4.x & 0xffff0000u), __builtin_bit_cast(float, b4.y << 16), __builtin_bit_cast(float, b4.y & 0xffff0000u)};
                        const f32x4 b1 = (f32x4){__builtin_bit_cast(float, b4.z << 16), __builtin_bit_cast(float, b4.z & 0xffff0000u), __builtin_bit_cast(float, b4.w << 16), __builtin_bit_cast(float, b4.w & 0xffff0000u)};
                        const f32x4 h0 = b0 + alpha * acc[ai][bj][m][0], h1 = b1 + alpha * acc[ai][bj][m][1];
                        u32x4 w; w.x = cvt_pk_bf16(h0[0], h0[1]); w.y = cvt_pk_bf16(h0[2], h0[3]); w.z = cvt_pk_bf16(h1[0], h1[1]); w.w = cvt_pk_bf16(h1[2], h1[3]); *(u32x4*)(hout + off + bj * HALF) = w; } }
        } else {
#pragma unroll
            for (int ai = 0; ai < 2; ++ai) {
                f32x4 bv[4][2][2];
#pragma unroll
                for (int m = 0; m < 4; ++m) { const size_t off = (size_t)(row0 + ai * HALF + m * 16) * ldc + col0;
#pragma unroll
                    for (int bj = 0; bj < 2; ++bj)
#pragma unroll
                        for (int n = 0; n < 2; ++n) bv[m][bj][n] = *(const f32x4*)(bb + off + bj * HALF + n * 4); }
#pragma unroll
                for (int m = 0; m < 4; ++m) { const size_t off = (size_t)(row0 + ai * HALF + m * 16) * ldc + col0;
#pragma unroll
                    for (int bj = 0; bj < 2; ++bj) { const f32x4 h0 = bv[m][bj][0] + alpha * acc[ai][bj][m][0], h1 = bv[m][bj][1] + alpha * acc[ai][bj][m][1];
                        u32x4 w; w.x = cvt_pk_bf16(h0[0], h0[1]); w.y = cvt_pk_bf16(h0[2], h0[3]); w.z = cvt_pk_bf16(h1[0], h1[1]); w.w = cvt_pk_bf16(h1[2], h1[3]); *(u32x4*)(hout + off + bj * HALF) = w; } }
                asm volatile("" ::: "memory"); }
        }
    }
};
struct EpiZ {
    static constexpr bool PERM = true, AFTER_DRAIN = false;
    bf16_t* Z; int ldz; const float* rcos; const float* rsin;
    __device__ __forceinline__ void operator()(const f32x4 (&acc)[2][2][4][2], const Unit& u, int wr, int wc, int fr, int fq) const {
        const int row0 = u.pm * BM + wr * 64 + fr, col0 = u.pn * BM + wc * 32 + 8 * fq;
        const bool rope = u.pn < 16; const float sc = (u.pn >= 8 && u.pn < 16) ? 0.0625f : 1.0f;
#pragma unroll
        for (int ai = 0; ai < 2; ++ai)
#pragma unroll
            for (int m = 0; m < 4; ++m) { const int r = row0 + ai * HALF + m * 16; bf16_t* rowp = Z + (size_t)r * ldz + col0;
                f32x4 a0 = acc[ai][0][m][0], a1 = acc[ai][0][m][1], b0 = acc[ai][1][m][0], b1 = acc[ai][1][m][1];
                if (rope) { const int pos = r < 16384 ? (r & 8191) : 1024 + ((r - 16384) & 63);
                    const float* cp = rcos + (size_t)pos * 128 + wc * 32 + 8 * fq; const float* sp = rsin + (size_t)pos * 128 + wc * 32 + 8 * fq;
                    const f32x4 c0 = *(const f32x4*)cp, c1 = *(const f32x4*)(cp + 4), s0 = *(const f32x4*)sp, s1 = *(const f32x4*)(sp + 4);
                    const f32x4 x0 = a0, x1 = a1, y0 = b0, y1 = b1;
                    a0 = (x0 * c0 - y0 * s0) * sc; a1 = (x1 * c1 - y1 * s1) * sc; b0 = (y0 * c0 + x0 * s0) * sc; b1 = (y1 * c1 + x1 * s1) * sc; }
                u32x4 w; w.x = cvt_pk_bf16(a0[0], a0[1]); w.y = cvt_pk_bf16(a0[2], a0[3]); w.z = cvt_pk_bf16(a1[0], a1[1]); w.w = cvt_pk_bf16(a1[2], a1[3]);
                *(u32x4*)rowp = w;
                w.x = cvt_pk_bf16(b0[0], b0[1]); w.y = cvt_pk_bf16(b0[2], b0[3]); w.z = cvt_pk_bf16(b1[0], b1[1]); w.w = cvt_pk_bf16(b1[2], b1[3]);
                *(u32x4*)(rowp + HALF) = w; }
    }
};
struct EpiBf16P {
    static constexpr bool PERM = true, AFTER_DRAIN = false;
    bf16_t* O; int ldc;
    __device__ __forceinline__ void operator()(const f32x4 (&acc)[2][2][4][2], const Unit& u, int wr, int wc, int fr, int fq) const {
        const int row0 = u.pm * BM + wr * 64 + fr, col0 = u.pn * BM + wc * 32 + 8 * fq;
#pragma unroll
        for (int ai = 0; ai < 2; ++ai)
#pragma unroll
            for (int m = 0; m < 4; ++m) { bf16_t* rowp = O + (size_t)(row0 + ai * HALF + m * 16) * ldc + col0;
#pragma unroll
                for (int bj = 0; bj < 2; ++bj) { const f32x4 v0 = acc[ai][bj][m][0], v1 = acc[ai][bj][m][1];
                    u32x4 w; w.x = cvt_pk_bf16(v0[0], v0[1]); w.y = cvt_pk_bf16(v0[2], v0[3]); w.z = cvt_pk_bf16(v1[0], v1[1]); w.w = cvt_pk_bf16(v1[2], v1[3]);
                    *(u32x4*)(rowp + bj * HALF) = w; } }
    }
};
struct EpiKNorm {
    static constexpr bool PERM = true, AFTER_DRAIN = false;
    bf16_t* O; int ldc; const float* gk; PG8_LAS float* tab;
    __device__ __forceinline__ void operator()(const f32x4 (&acc)[2][2][4][2], const Unit& u, int wr, int wc, int fr, int fq) const {
        const int row0 = u.pm * BM + wr * 64 + fr, col0 = u.pn * BM + wc * 32 + 8 * fq;
#pragma unroll
        for (int ai = 0; ai < 2; ++ai)
#pragma unroll
            for (int m = 0; m < 4; ++m)
#pragma unroll
                for (int bj = 0; bj < 2; ++bj) { const f32x4 v0 = acc[ai][bj][m][0], v1 = acc[ai][bj][m][1];
                    float ss = (v0[0] * v0[0] + v0[1] * v0[1]) + (v0[2] * v0[2] + v0[3] * v0[3]) + (v1[0] * v1[0] + v1[1] * v1[1]) + (v1[2] * v1[2] + v1[3] * v1[3]);
                    ss += __shfl_xor(ss, 16); ss += __shfl_xor(ss, 32);
                    if (fq == 0) tab[((ai * HALF + wr * 64 + m * 16 + fr) * 2 + bj) * 4 + wc] = ss; }
        asm volatile("s_waitcnt lgkmcnt(0)" ::: "memory"); __builtin_amdgcn_s_barrier(); asm volatile("" ::: "memory");
        const f32x4 g0 = *(const f32x4*)(gk + wc * 32 + 8 * fq), g1 = *(const f32x4*)(gk + wc * 32 + 8 * fq + 4);
#pragma unroll
        for (int ai = 0; ai < 2; ++ai)
#pragma unroll
            for (int m = 0; m < 4; ++m) { bf16_t* rowp = O + (size_t)(row0 + ai * HALF + m * 16) * ldc + col0;
#pragma unroll
                for (int bj = 0; bj < 2; ++bj) { const f32x4 pr = *(const PG8_LAS f32x4*)(tab + ((ai * HALF + wr * 64 + m * 16 + fr) * 2 + bj) * 4);
                    const float rs = __builtin_amdgcn_rsqf(((pr[0] + pr[1]) + (pr[2] + pr[3])) * (1.0f / 128.0f) + 1e-6f);
                    const f32x4 v0 = acc[ai][bj][m][0] * rs * g0, v1 = acc[ai][bj][m][1] * rs * g1;
                    u32x4 w; w.x = cvt_pk_bf16(v0[0], v0[1]); w.y = cvt_pk_bf16(v0[2], v0[3]); w.z = cvt_pk_bf16(v1[0], v1[1]); w.w = cvt_pk_bf16(v1[2], v1[3]);
                    *(u32x4*)(rowp + bj * HALF) = w; } }
    }
};
template <class Epi, class Sched, bool ALIGN_EPI = false, bool SP2 = false>
__device__ __forceinline__ void gemm_phase(PG8_LAS unsigned char* lds, const Gemm g, const Sched& S, const Epi& E) {
    const int tid = threadIdx.x, wid = __builtin_amdgcn_readfirstlane(tid >> 6), lane = tid & 63, wr = wid >> 2, wc = wid & 3, fr = lane & 15, fq = lane >> 4;
    const int K = g.K;
    unsigned voffA[2], voffB[2];
#pragma unroll
    for (int i = 0; i < 2; ++i) { int R, C; stage_rc(tid * 16 + i * 8192, R, C); const int Rb = Epi::PERM ? ((R & ~31) + perm32(R & 31)) : R;
        voffA[i] = (unsigned)(R * K + C) * 2u; voffB[i] = (unsigned)(Rb * K + C) * 2u; }
    const size_t kstep = (size_t)(BK * 2);
    const size_t hstep = (size_t)HALF * K * 2;
    const size_t tstep = 2 * hstep;
    const unsigned ldsw = (unsigned)wid * 1024u;
    const int aoff = lds_byte(wr * 64 + fr, fq * 8), boff = lds_byte(wc * 32 + fr, fq * 8);
#define PG8_SA(b, h) (((b) * 2 + (h)) * HTB)
#define PG8_SB(b, h) ((4 + (b) * 2 + (h)) * HTB)
#define PG8_STAGE(bufoff, gbase, voff) do { _Pragma("unroll") for (int _i = 0; _i < 2; ++_i) \
        __builtin_amdgcn_global_load_lds((const unsigned*)((const char*)(gbase) + (voff)[_i]), (PG8_LAS unsigned*)(lds + (bufoff) + ldsw + _i * 8192), 16, 0, 0); } while (0)
#define PG8_LDA(dst, b, h) do { _Pragma("unroll") for (int m = 0; m < 4; ++m) _Pragma("unroll") for (int k = 0; k < 2; ++k) dst[m][k] = *(const PG8_LAS bf16x8*)(lds + PG8_SA(b, h) + aoff + m * 2048 + k * 1024); } while (0)
#define PG8_LDB(dst, b, h) do { _Pragma("unroll") for (int n = 0; n < 2; ++n) _Pragma("unroll") for (int k = 0; k < 2; ++k) dst[n][k] = *(const PG8_LAS bf16x8*)(lds + PG8_SB(b, h) + boff + n * 2048 + k * 1024); } while (0)
#define PG8_MMA(ai, bj, At, Bt) do { __builtin_amdgcn_s_setprio(1); _Pragma("unroll") for (int m = 0; m < 4; ++m) _Pragma("unroll") for (int n = 0; n < 2; ++n) _Pragma("unroll") for (int k = 0; k < 2; ++k) \
        acc[ai][bj][m][n] = __builtin_amdgcn_mfma_f32_16x16x32_bf16(Bt[n][k], At[m][k], acc[ai][bj][m][n], 0, 0, 0); __builtin_amdgcn_s_setprio(0); } while (0)
#define PG8_WAIT_V(n) asm volatile("s_waitcnt vmcnt(" #n ")" ::: "memory")
#define PG8_WAIT_L(n) asm volatile("s_waitcnt lgkmcnt(" #n ")" ::: "memory")
#define PG8_BAR __builtin_amdgcn_s_barrier()
#define PG8_SCHED __builtin_amdgcn_sched_barrier(0)
    Unit cur, nxt; int ui = 0;
    if (!S.next(0, cur)) return;
    f32x4 acc[2][2][4][2];
#pragma unroll
    for (int a = 0; a < 2; ++a)
#pragma unroll
        for (int b = 0; b < 2; ++b)
#pragma unroll
            for (int m = 0; m < 4; ++m)
#pragma unroll
                for (int n = 0; n < 2; ++n) acc[a][b][m][n] = (f32x4){0.f, 0.f, 0.f, 0.f};
    bf16x8 At[4][2], B0[2][2], B1[2][2];
    const char* cA = (const char*)g.A + (size_t)cur.pm * tstep + (size_t)cur.kt0 * kstep; const char* cB = (const char*)g.Bt + (size_t)cur.pn * tstep + (size_t)cur.kt0 * kstep;
    S.a_ready(cur);
    if constexpr (SP2) {
        PG8_STAGE(PG8_SB(0, 0), cB, voffB); PG8_STAGE(PG8_SB(0, 1), cB + hstep, voffB); PG8_STAGE(PG8_SA(0, 0), cA, voffA); PG8_STAGE(PG8_SA(0, 1), cA + hstep, voffA);
        if (wr == 1) PG8_BAR;
        PG8_WAIT_V(2); PG8_BAR;
        PG8_STAGE(PG8_SB(1, 0), cB + kstep, voffB); PG8_STAGE(PG8_SA(1, 0), cA + kstep, voffA); PG8_STAGE(PG8_SB(1, 1), cB + hstep + kstep, voffB);
        PG8_WAIT_V(6); PG8_BAR;
    } else {
        PG8_STAGE(PG8_SB(0, 0), cB, voffB); PG8_STAGE(PG8_SA(0, 0), cA, voffA); PG8_STAGE(PG8_SB(0, 1), cB + hstep, voffB); PG8_STAGE(PG8_SA(0, 1), cA + hstep, voffA);
        if (wr == 1) PG8_BAR;
        PG8_WAIT_V(4); PG8_BAR;
        PG8_STAGE(PG8_SB(1, 0), cB + kstep, voffB); PG8_STAGE(PG8_SA(1, 0), cA + kstep, voffA); PG8_STAGE(PG8_SB(1, 1), cB + hstep + kstep, voffB);
        PG8_WAIT_V(6); PG8_BAR;
    }
    for (;;) {
        const bool has_next = S.next(ui + 1, nxt);
        const char* nA = has_next ? (const char*)g.A + (size_t)nxt.pm * tstep + (size_t)nxt.kt0 * kstep : cA; const char* nB = has_next ? (const char*)g.Bt + (size_t)nxt.pn * tstep + (size_t)nxt.kt0 * kstep : cB;
        const int nt = cur.nt;
        for (int t = 0; t < nt; t += 2) {
            const bool last = (t == nt - 2);
            const char* a1 = cA + (size_t)(t + 1) * kstep;
            const char* a2 = last ? nA : cA + (size_t)(t + 2) * kstep; const char* b2 = last ? nB : cB + (size_t)(t + 2) * kstep;
            const char* a3 = a2 + kstep; const char* b3 = b2 + kstep;
            if (last && has_next) S.a_ready(nxt);
            if constexpr (SP2) {
            PG8_LDB(B0, 0, 0); PG8_LDB(B1, 0, 1); PG8_SCHED; PG8_LDA(At, 0, 0); PG8_STAGE(PG8_SA(1, 1), a1 + hstep, voffA);
            PG8_WAIT_V(8); PG8_WAIT_L(0); PG8_BAR; PG8_MMA(0, 0, At, B0); PG8_MMA(0, 1, At, B1); PG8_BAR; PG8_SCHED;
            PG8_LDA(At, 0, 1); PG8_STAGE(PG8_SB(0, 0), b2, voffB); PG8_STAGE(PG8_SB(0, 1), b2 + hstep, voffB); PG8_STAGE(PG8_SA(0, 0), a2, voffA);
            PG8_WAIT_V(8); PG8_WAIT_L(0); PG8_BAR; PG8_MMA(1, 0, At, B0); PG8_MMA(1, 1, At, B1); PG8_BAR; PG8_SCHED;
            PG8_LDB(B0, 1, 0); PG8_LDB(B1, 1, 1); PG8_SCHED; PG8_LDA(At, 1, 0); PG8_STAGE(PG8_SA(0, 1), a2 + hstep, voffA);
            PG8_WAIT_V(8); PG8_WAIT_L(0); PG8_BAR; PG8_MMA(0, 0, At, B0); PG8_MMA(0, 1, At, B1); PG8_BAR; PG8_SCHED;
            PG8_LDA(At, 1, 1); PG8_STAGE(PG8_SB(1, 0), b3, voffB); PG8_STAGE(PG8_SB(1, 1), b3 + hstep, voffB); PG8_STAGE(PG8_SA(1, 0), a3, voffA);
            PG8_WAIT_V(8); PG8_WAIT_L(0); PG8_BAR; PG8_MMA(1, 0, At, B0); PG8_MMA(1, 1, At, B1); PG8_BAR; PG8_SCHED;
            } else {
            PG8_LDB(B0, 0, 0); PG8_SCHED; PG8_LDA(At, 0, 0); PG8_STAGE(PG8_SA(1, 1), a1 + hstep, voffA);
            PG8_WAIT_L(8); PG8_BAR; PG8_WAIT_L(0); PG8_MMA(0, 0, At, B0); PG8_BAR; PG8_SCHED;
            PG8_LDB(B1, 0, 1); PG8_STAGE(PG8_SB(0, 0), b2, voffB);
            PG8_BAR; PG8_WAIT_L(0); PG8_MMA(0, 1, At, B1); PG8_BAR;
            PG8_LDA(At, 0, 1); PG8_STAGE(PG8_SA(0, 0), a2, voffA);
            PG8_BAR; PG8_WAIT_L(0); PG8_MMA(1, 0, At, B0); PG8_BAR; PG8_SCHED;
            PG8_STAGE(PG8_SB(0, 1), b2 + hstep, voffB);
            PG8_WAIT_V(6); PG8_BAR; PG8_MMA(1, 1, At, B1); PG8_BAR;
            PG8_LDB(B0, 1, 0); PG8_SCHED; PG8_LDA(At, 1, 0); PG8_STAGE(PG8_SA(0, 1), a2 + hstep, voffA);
            PG8_WAIT_L(8); PG8_BAR; PG8_WAIT_L(0); PG8_MMA(0, 0, At, B0); PG8_BAR; PG8_SCHED;
            PG8_LDB(B1, 1, 1); PG8_STAGE(PG8_SB(1, 0), b3, voffB);
            PG8_BAR; PG8_WAIT_L(0); PG8_MMA(0, 1, At, B1); PG8_BAR;
            PG8_LDA(At, 1, 1); PG8_STAGE(PG8_SA(1, 0), a3, voffA);
            PG8_BAR; PG8_WAIT_L(0); PG8_MMA(1, 0, At, B0); PG8_BAR; PG8_SCHED;
            PG8_STAGE(PG8_SB(1, 1), b3 + hstep, voffB);
            PG8_WAIT_V(6); PG8_BAR; PG8_MMA(1, 1, At, B1); PG8_BAR;
            }
        }
        if constexpr (ALIGN_EPI) { if (wr == 0) PG8_BAR; }
        if constexpr (!Epi::AFTER_DRAIN) { E(acc, cur, wr, wc, fr, fq); S.done(cur); }
        if (!has_next) break;
#pragma unroll
        for (int a = 0; a < 2; ++a)
#pragma unroll
            for (int b = 0; b < 2; ++b)
#pragma unroll
                for (int m = 0; m < 4; ++m)
#pragma unroll
                    for (int n = 0; n < 2; ++n) acc[a][b][m][n] = (f32x4){0.f, 0.f, 0.f, 0.f};
        cur = nxt; cA = nA; cB = nB; ++ui;
        if constexpr (ALIGN_EPI) { if (wr == 1) PG8_BAR; }
    }
    PG8_WAIT_V(0);
    if constexpr (!ALIGN_EPI) { if (wr == 0) PG8_BAR; }
    PG8_BAR;
    if constexpr (Epi::AFTER_DRAIN) { E.fused(acc, cur, wr, wc, fr, fq, lds, wid, lane); S.done(cur); }
#undef PG8_SA
#undef PG8_SB
#undef PG8_STAGE
#undef PG8_LDA
#undef PG8_LDB
#undef PG8_MMA
#undef PG8_WAIT_V
#undef PG8_WAIT_L
#undef PG8_BAR
#undef PG8_SCHED
}
}

constexpr int DM = 4096, TP = 16384, TS = 512, TT = TP + TS, SEQ = 8192, DFF = 11008, DIN = 9792, ZLD = 9984;
constexpr int KROWS = 25088;
constexpr int QLD = 3072, KNLD = 2048;
constexpr float EPSN = 1e-6f;
#ifndef MK_WGM_DOWN
#define MK_WGM_DOWN 2
#endif
#ifndef MK_YSCALE
#define MK_YSCALE 1.0f
#endif
constexpr float QSCALE = 0.07216878364870322f * 1.4426950408889634f;
constexpr size_t O_YP = 0, O_YS = 67108864, O_SRP = 69206016, O_CKP = 70254592, O_KRP = 78643200, O_SRS = 79691776, O_CKS = 83886080, O_KRS = 84148224, O_END = 84180992;
constexpr size_t MiB = 1u << 20;
constexpr size_t WS_CTL = 0, CTL_ZERO_BYTES = 1 * MiB;
constexpr size_t WS_W1GU = 1 * MiB;
constexpr size_t WS_W1D  = WS_W1GU + 172 * MiB;
constexpr size_t WS_KN   = WS_W1GU;
constexpr size_t WS_VT   = WS_W1GU + 98 * MiB;
constexpr size_t WS_W2GU = WS_W1D + 86 * MiB;
constexpr size_t WS_W2D  = WS_W2GU + 172 * MiB;
constexpr size_t WS_WIN  = WS_W2D + 86 * MiB;
constexpr size_t WS_WUQ  = WS_WIN + 78 * MiB;
constexpr size_t WS_WUK  = WS_WUQ + 6 * MiB;
constexpr size_t WS_WUV  = WS_WUK + 2 * MiB;
constexpr size_t WS_WOUT = WS_WUV + 2 * MiB;
constexpr size_t WS_XN   = WS_WOUT + 32 * MiB;
constexpr size_t WS_HID  = WS_XN + 132 * MiB;
constexpr size_t WS_Z    = WS_HID;
constexpr size_t WS_QAN  = WS_HID + 322 * MiB;
constexpr size_t WS_QH   = WS_HID + 355 * MiB;
constexpr size_t WS_CALL = WS_QH + 99 * MiB;
constexpr size_t WS_KR   = WS_CALL + 25 * MiB;
constexpr size_t WS_TAB  = WS_KR + 4 * MiB;
constexpr size_t WS_SLAB = WS_TAB + 10 * MiB;
constexpr size_t WS_HB   = WS_SLAB + 64 * MiB;
constexpr size_t WS_END  = WS_HB + 132 * MiB;
static_assert((size_t)TT * ZLD * 2 <= 322 * MiB && (size_t)TT * 1024 * 2 <= 33 * MiB && (size_t)TT * DFF * 2 <= 355 * MiB && (size_t)KROWS * 2048 * 2 <= 98 * MiB, "ws map");
constexpr int CW_QUEUE = 64;
constexpr int CW_BGQ = 2048;
constexpr int CW_BAR = 4096;
constexpr int RING_BYTES = 131072, MISC_OFF = RING_BYTES + 320, LDS_BYTES = 147456;

#define GAS __attribute__((address_space(1)))
#define LAS __attribute__((address_space(3)))
typedef unsigned short bf16;
typedef unsigned v4u __attribute__((ext_vector_type(4)));
typedef unsigned v2u __attribute__((ext_vector_type(2)));
typedef float f32x4 __attribute__((ext_vector_type(4)));
typedef float f32x16 __attribute__((ext_vector_type(16)));
typedef short bf16x8 __attribute__((ext_vector_type(8)));
typedef short s16x4 __attribute__((ext_vector_type(4)));
#define LDS_WAIT() asm volatile("s_waitcnt lgkmcnt(0)" ::: "memory")
#define VM_WAIT() asm volatile("s_waitcnt vmcnt(0)" ::: "memory")
__device__ __forceinline__ unsigned f2bf(float f) { unsigned u = __builtin_bit_cast(unsigned, f); return (u + 0x7fffu + ((u >> 16) & 1u)) >> 16; }
__device__ __forceinline__ unsigned pk2(float lo, float hi) { return pg8::cvt_pk_bf16(lo, hi); }
__device__ __forceinline__ float bflo(unsigned w) { return __builtin_bit_cast(float, w << 16); }
__device__ __forceinline__ float bfhi(unsigned w) { return __builtin_bit_cast(float, w & 0xffff0000u); }
__device__ __forceinline__ float ex2(float x) { return __builtin_amdgcn_exp2f(x); }
#define XB_TMO      128
#define XB_XCNT(j)  (256  + 64 * (j))
#define XB_XSUB(j)  (1280 + 64 * (j))
#define XB_XGEN(j)  (2304 + 64 * (j))
#define XB_TOP      3328
#define XB_TOPGEN   3392
#define XCD_BAR_WORDS 3456
#define XB_SPIN_CAP (1u << 18)

__device__ __forceinline__ unsigned xb_ld(unsigned* p)              { return __hip_atomic_load(p, __ATOMIC_RELAXED, __HIP_MEMORY_SCOPE_AGENT); }
__device__ __forceinline__ unsigned xb_add(unsigned* p, unsigned v) { return __hip_atomic_fetch_add(p, v, __ATOMIC_RELAXED, __HIP_MEMORY_SCOPE_AGENT); }
__device__ __forceinline__ unsigned xb_xcc_id() { return (unsigned)__builtin_amdgcn_s_getreg((3 << 11) | 20) & 0xFu; }
#define XB_SPIN(cond, bar) do { unsigned _sp = 0; while (cond) { __builtin_amdgcn_s_sleep(1); \
    if ((++_sp & 255u) == 0u) { if (xb_ld(&(bar)[XB_TMO])) break; if (_sp > XB_SPIN_CAP) { atomicAdd(&(bar)[XB_TMO], 1u); break; } } } } while (0)

struct XcdBarrier {
    unsigned* bar; unsigned x;
    volatile LAS unsigned* st;
};

__device__ __forceinline__ XcdBarrier xcd_barrier_post(unsigned* bar, volatile LAS unsigned* st) {
    XcdBarrier b; b.bar = bar; b.x = xb_xcc_id(); b.st = st;
    if (threadIdx.x == 0) (void)xb_add(&bar[XB_XCNT(b.x)], 1u);
    return b;
}
__device__ __forceinline__ void xcd_barrier_complete(unsigned* bar, unsigned x, unsigned& nloc, unsigned& nx) {
    const unsigned G = gridDim.x * gridDim.y * gridDim.z;
    unsigned sum, cnt, mine, sp = 0u;
    for (;;) {
        sum = 0u; cnt = 0u; mine = 0u;
#pragma unroll
        for (unsigned j = 0; j < 16; ++j) { const unsigned c = xb_ld(&bar[XB_XCNT(j)]); sum += c; cnt += (c > 0u) ? 1u : 0u; mine = (j == x) ? c : mine; }
        if (sum == G) break;
        __builtin_amdgcn_s_sleep(1);
        if ((++sp & 255u) == 0u) { if (xb_ld(&bar[XB_TMO])) break; if (sp > XB_SPIN_CAP) { atomicAdd(&bar[XB_TMO], 1u); break; } }
    }
    nloc = mine > 0u ? mine : 1u; nx = cnt > 0u ? cnt : 1u;
}

__device__ __forceinline__ void xcd_barrier(const XcdBarrier& b) {
    asm volatile("s_waitcnt vmcnt(0)" ::: "memory");
    __syncthreads();
    if (threadIdx.x == 0) {
        unsigned* bar = b.bar;
        __builtin_amdgcn_s_waitcnt(0);
        unsigned nloc = b.st[0], nx = b.st[1];
        if (nloc == 0u) { xcd_barrier_complete(bar, b.x, nloc, nx); b.st[0] = nloc; b.st[1] = nx; }
        const unsigned old = xb_add(&bar[XB_XSUB(b.x)], 1u);
        const unsigned gen = old / nloc;
        if (old + 1u == (gen + 1u) * nloc) {
            __builtin_amdgcn_fence(__ATOMIC_RELEASE, "agent");
            asm volatile("s_waitcnt vmcnt(0)" ::: "memory");
            const unsigned og = xb_add(&bar[XB_TOP], 1u);
            const unsigned tg = og / nx;
            if (og + 1u == (tg + 1u) * nx) xb_add(&bar[XB_TOPGEN], 1u);
            else XB_SPIN(xb_ld(&bar[XB_TOPGEN]) == tg, bar);
            __builtin_amdgcn_fence(__ATOMIC_ACQUIRE, "agent");
            xb_add(&bar[XB_XGEN(b.x)], 1u);
            asm volatile("s_waitcnt vmcnt(0)" ::: "memory");
        } else {
            XB_SPIN(xb_ld(&bar[XB_XGEN(b.x)]) == gen, bar);
            __builtin_amdgcn_fence(__ATOMIC_ACQUIRE, "agent");
            asm volatile("s_waitcnt vmcnt(0)" ::: "memory");
        }
    }
    __syncthreads();
}

__device__ __forceinline__ float wave_sum(float v) {
#pragma unroll
    for (int o = 1; o < 64; o <<= 1) v += __shfl_xor(v, o);
    return v;
}
__device__ __forceinline__ void tr_load(f32x4 (&wv)[8], const float* __restrict__ W, int N, int k0, int n0, int lane) {
#pragma unroll
    for (int i = 0; i < 8; ++i) wv[i] = __builtin_nontemporal_load((const GAS f32x4*)(W + (size_t)(k0 + 8 * i + (lane >> 3)) * N + n0 + 4 * (lane & 7)));
}
__device__ __forceinline__ void tr_store(const f32x4 (&wv)[8], int K, bf16* dst, LAS float* scr, int k0, int lane) {
#pragma unroll
    for (int i = 0; i < 8; ++i) { LAS float* d = scr + (8 * i + (lane >> 3)) * 33 + 4 * (lane & 7); d[0] = wv[i].x; d[1] = wv[i].y; d[2] = wv[i].z; d[3] = wv[i].w; }
    LDS_WAIT(); asm volatile("" ::: "memory");
    const int c = lane & 7;
#pragma unroll
    for (int j = 0; j < 4; ++j) { const int n = (lane >> 3) + 8 * j; const LAS float* s = scr + (8 * c) * 33 + n;
        v4u o; o.x = pk2(s[0 * 33], s[1 * 33]); o.y = pk2(s[2 * 33], s[3 * 33]); o.z = pk2(s[4 * 33], s[5 * 33]); o.w = pk2(s[6 * 33], s[7 * 33]);
        *(GAS v4u*)(dst + (size_t)n * K + k0 + 8 * c) = o; }
    LDS_WAIT(); asm volatile("" ::: "memory");
}
__device__ __forceinline__ void convert_decode(int K, int N, int mode, bf16* dstA, bf16* dstB, int it, int& k0, int& n0, bf16*& d) {
    const int nblk = N / 32;
    const int kb = it / nblk, nb = it - kb * nblk; n0 = 32 * nb; k0 = 64 * kb;
    if (mode == 0) d = dstA + (size_t)n0 * K;
    else if (mode == 1) d = dstA + (size_t)(256 * (n0 >> 7) + (n0 & 127)) * K;
    else if (mode == 2) d = dstA + (size_t)(256 * (n0 >> 7) + 128 + (n0 & 127)) * K;
    else { const int hh = n0 >> 8, x = n0 & 255; d = (x < 128) ? dstA + (size_t)(hh * 128 + x) * K : dstB + (size_t)(hh * 128 + x - 128) * K; }
}
__device__ __forceinline__ void convert_item(const float* __restrict__ W, int K, int N, int mode, bf16* dstA, bf16* dstB, LAS float* scr, int it, int lane) {
    int k0, n0; bf16* d; convert_decode(K, N, mode, dstA, dstB, it, k0, n0, d);
    f32x4 wv[8]; tr_load(wv, W, N, k0, n0, lane); tr_store(wv, K, d, scr, k0, lane);
}
__device__ __forceinline__ void convert_items4(const float* __restrict__ W, int K, int N, int mode, bf16* dstA, bf16* dstB, LAS float* scr, int it, int lane) {
    int k0[4], n0[4]; bf16* d[4]; f32x4 wv[4][8];
#pragma unroll
    for (int b = 0; b < 4; ++b) { convert_decode(K, N, mode, dstA, dstB, it + b, k0[b], n0[b], d[b]); tr_load(wv[b], W, N, k0[b], n0[b], lane); }
#pragma unroll
    for (int b = 0; b < 4; ++b) tr_store(wv[b], K, d[b], scr, k0[b], lane);
}
__device__ __forceinline__ void convert_weight(const float* __restrict__ W, int K, int N, int mode, bf16* dstA, bf16* dstB, LAS float* scr, int gw, int NGW, int lane) {
    const int nitems = (K / 64) * (N / 32);
    for (int it = gw; it < nitems; it += NGW) convert_item(W, K, N, mode, dstA, dstB, scr, it, lane);
}
__device__ __forceinline__ void sincos_tab(int pos, int i, int n, float& c, float& s) {
    const float inv = __builtin_exp2f(-(float)i * (13.287712379549449f / (float)n));
    const double ang = (double)pos * (double)inv;
    const double k = __builtin_rint(ang * 0.63661977236758134);
    const double r = (ang - k * 1.5707963267948966) - k * 6.123233995736766e-17;
    const double r2 = r * r;
    const double sn = r * (1.0 + r2 * (-1.0 / 6 + r2 * (1.0 / 120 + r2 * (-1.0 / 5040 + r2 * (1.0 / 362880 + r2 * (-1.0 / 39916800))))));
    const double cs = 1.0 + r2 * (-0.5 + r2 * (1.0 / 24 + r2 * (-1.0 / 720 + r2 * (1.0 / 40320 + r2 * (-1.0 / 3628800 + r2 * (1.0 / 479001600))))));
    const int q = ((int)k) & 3;
    const double cc = (q == 0) ? cs : (q == 1) ? -sn : (q == 2) ? -cs : sn;
    const double ss = (q == 0) ? sn : (q == 1) ? cs : (q == 2) ? -sn : -cs;
    c = (float)cc; s = (float)ss;
}
__device__ __forceinline__ void build_split_tab(LAS unsigned char* tab, int G, int K, int tid, int wgm) {
    for (int i = tid; i < 66 * 16; i += 512) tab[i] = 0xff;
    __syncthreads();
    pg8::SplitTailOrder S; S.init(TT, DM, G, 0, K); S.wgm = wgm; const int R = S.nwg / G, rem = S.nwg - R * G;
    if (tid < rem) { pg8::Unit u; S.tile(R * G + tid, u); tab[u.pm * 16 + u.pn] = (unsigned char)tid; }
    __syncthreads();
    if (tid < 66) { unsigned m = 0u;
        for (int j = 0; j < 16; ++j) m |= (tab[tid * 16 + j] != 0xff ? 1u : 0u) << j;
        ((LAS unsigned short*)(tab + 1088))[tid] = (unsigned short)m; }
    __syncthreads();
}
__device__ __forceinline__ void split_fixup(f32x4 (&v)[16], float* hrow, int r, const LAS unsigned char* tab, const float* __restrict__ slabs, float alpha, int lane) {
    const int pm = r >> 8;
#pragma unroll
    for (int j = 0; j < 16; ++j) {
        const int slot = __builtin_amdgcn_readfirstlane((int)tab[pm * 16 + j]);
        if (slot != 0xff) {
            const GAS f32x4* sp = (const GAS f32x4*)(slabs + (size_t)slot * 8 * 65536 + (size_t)(r & 255) * 256) + lane;
            f32x4 a = sp[0];
#pragma unroll
            for (int p = 1; p < 8; ++p) a = a + sp[(size_t)p * 16384];
            v[j] = v[j] + alpha * a;
            ((GAS f32x4*)hrow)[lane + 64 * j] = v[j];
        }
    }
}
template <bool FIX>
__device__ __forceinline__ void rms_row_bf16(float* xrow, const float* __restrict__ g, bf16* orow, int lane, int r, const LAS unsigned char* tab, const float* slabs, float alpha) {
    const GAS f32x4* xr = (const GAS f32x4*)xrow + lane;
    f32x4 v[16]; float s = 0.f;
#pragma unroll
    for (int j = 0; j < 16; ++j) v[j] = xr[64 * j];
    if (FIX) split_fixup(v, xrow, r, tab, slabs, alpha, lane);
#pragma unroll
    for (int j = 0; j < 16; ++j) s += (v[j].x * v[j].x + v[j].y * v[j].y) + (v[j].z * v[j].z + v[j].w * v[j].w);
    const float rinv = 1.0f / sqrtf(wave_sum(s) * (1.0f / 4096.0f) + EPSN);
    const GAS f32x4* gr = (const GAS f32x4*)g + lane;
    GAS v2u* o8 = (GAS v2u*)orow + lane;
#pragma unroll
    for (int j = 0; j < 16; ++j) { const f32x4 gv = gr[64 * j]; v2u w; w.x = pk2(v[j].x * rinv * gv.x, v[j].y * rinv * gv.y); w.y = pk2(v[j].z * rinv * gv.z, v[j].w * rinv * gv.w); o8[64 * j] = w; }
}
__device__ __forceinline__ void rms_row_f32_inplace(float* xrow, const float* __restrict__ g, int lane, int r, const LAS unsigned char* tab, const float* slabs, float alpha) {
    GAS f32x4* xr = (GAS f32x4*)xrow + lane;
    f32x4 v[16]; float s = 0.f;
#pragma unroll
    for (int j = 0; j < 16; ++j) v[j] = xr[64 * j];
    split_fixup(v, xrow, r, tab, slabs, alpha, lane);
#pragma unroll
    for (int j = 0; j < 16; ++j) s += (v[j].x * v[j].x + v[j].y * v[j].y) + (v[j].z * v[j].z + v[j].w * v[j].w);
    const float rinv = 1.0f / sqrtf(wave_sum(s) * (1.0f / 4096.0f) + EPSN);
    const GAS f32x4* gr = (const GAS f32x4*)g + lane;
#pragma unroll
    for (int j = 0; j < 16; ++j) { const f32x4 gv = gr[64 * j]; xr[64 * j] = v[j] * rinv * gv * MK_YSCALE; }
}
template <bool FIX, bool TO_BF16>
__device__ __forceinline__ void norm_phase(const float* x_p, const float* x_s  , const float* __restrict__ g, bf16* XNo, float* fout,
                                           int gw, int NGW, int lane, const LAS unsigned char* tab, const float* slabs, float alpha) {
    f32x4 gv[16], v[16], nx[16];
    constexpr bool W8 = TO_BF16 && !FIX;
#define NP_IDX(j) (W8 ? (2 * lane + 128 * ((j) >> 1) + ((j) & 1)) : (lane + 64 * (j)))
    { const GAS f32x4* gr = (const GAS f32x4*)g;
#pragma unroll
      for (int j = 0; j < 16; ++j) gv[j] = gr[NP_IDX(j)]; }
#define NP_LOAD(dst, rr) do { const GAS f32x4* xr_ = (const GAS f32x4*)((rr) < TP ? x_p + (size_t)(rr) * DM : x_s + (size_t)((rr) - TP) * DM); _Pragma("unroll") for (int j = 0; j < 16; ++j) dst[j] = __builtin_nontemporal_load(xr_ + NP_IDX(j)); } while (0)
    int r = gw;
    if (r < TT) NP_LOAD(v, r);
    for (; r < TT; r += NGW) {
        if (r + NGW < TT) NP_LOAD(nx, r + NGW);
        if (FIX) split_fixup(v, fout + (size_t)r * DM, r, tab, slabs, alpha, lane);
        float s = 0.f;
#pragma unroll
        for (int j = 0; j < 16; ++j) s += (v[j].x * v[j].x + v[j].y * v[j].y) + (v[j].z * v[j].z + v[j].w * v[j].w);
        const float rinv = 1.0f / sqrtf(wave_sum(s) * (1.0f / 4096.0f) + EPSN);
        if (W8) { GAS v4u* o16 = (GAS v4u*)(XNo + (size_t)r * DM) + lane;
#pragma unroll
            for (int jj = 0; jj < 8; ++jj) { const f32x4 a = v[2 * jj] * rinv * gv[2 * jj], b = v[2 * jj + 1] * rinv * gv[2 * jj + 1];
                v4u w; w.x = pk2(a.x, a.y); w.y = pk2(a.z, a.w); w.z = pk2(b.x, b.y); w.w = pk2(b.z, b.w); o16[64 * jj] = w; }
        } else if (TO_BF16) { GAS v2u* o8 = (GAS v2u*)(XNo + (size_t)r * DM) + lane;
#pragma unroll
            for (int j = 0; j < 16; ++j) { v2u w; w.x = pk2(v[j].x * rinv * gv[j].x, v[j].y * rinv * gv[j].y); w.y = pk2(v[j].z * rinv * gv[j].z, v[j].w * rinv * gv[j].w); o8[64 * j] = w; }
        } else { GAS f32x4* xr = (GAS f32x4*)(fout + (size_t)r * DM) + lane;
#pragma unroll
            for (int j = 0; j < 16; ++j) xr[64 * j] = v[j] * rinv * gv[j] * MK_YSCALE; }
#pragma unroll
        for (int j = 0; j < 16; ++j) v[j] = nx[j];
    }
#undef NP_LOAD
#undef NP_IDX
}
template <bool TO_BF16>
__device__ __forceinline__ void norm_phase_h(bf16* HB, const float* __restrict__ g, bf16* XNo, float* yout, int gw, int NGW, int lane, const LAS unsigned char* tab, const float* __restrict__ slabs, float alpha, int S) {
    f32x4 g0[8], g1[8]; v4u v[8], nx[8];
#pragma unroll
    for (int j = 0; j < 8; ++j) { const GAS f32x4* gp = (const GAS f32x4*)(g + 8 * (lane + 64 * j)); g0[j] = gp[0]; g1[j] = gp[1]; }
#define NH_LOAD(dst, rr) do { const GAS v4u* hr_ = (const GAS v4u*)(HB + (size_t)(rr) * DM) + lane; _Pragma("unroll") for (int j = 0; j < 8; ++j) dst[j] = hr_[64 * j]; } while (0)
    int r = gw;
    if (r < TT) NH_LOAD(v, r);
    for (; r < TT; r += NGW) {
        if (r + NGW < TT) NH_LOAD(nx, r + NGW);
        const int pm = r >> 8; float s = 0.f;
        const unsigned pmask = (unsigned)__builtin_amdgcn_readfirstlane((int)((const LAS unsigned short*)(tab + 1088))[pm]);
#pragma unroll
        for (int j = 0; j < 8; ++j) {
            f32x4 a0 = (f32x4){bflo(v[j].x), bfhi(v[j].x), bflo(v[j].y), bfhi(v[j].y)}, a1 = (f32x4){bflo(v[j].z), bfhi(v[j].z), bflo(v[j].w), bfhi(v[j].w)};
            if ((pmask >> (2 * j)) & 3u) {
                const int sl0 = __builtin_amdgcn_readfirstlane((int)tab[pm * 16 + 2 * j]), sl1 = __builtin_amdgcn_readfirstlane((int)tab[pm * 16 + 2 * j + 1]);
                const int slot = lane < 32 ? sl0 : sl1;
                if (slot != 0xff) {
                    const GAS v4u* sp = (const GAS v4u*)((const bf16*)slabs + (size_t)slot * S * 65536 + (size_t)(r & 255) * 256 + 8 * (lane & 31));
                    v4u pw[8];
#pragma unroll
                    for (int p = 0; p < 8; ++p) if (p < S) pw[p] = sp[(size_t)p * 8192];
                    f32x4 p0 = (f32x4){bflo(pw[0].x), bfhi(pw[0].x), bflo(pw[0].y), bfhi(pw[0].y)}, p1 = (f32x4){bflo(pw[0].z), bfhi(pw[0].z), bflo(pw[0].w), bfhi(pw[0].w)};
#pragma unroll
                    for (int p = 1; p < 8; ++p) if (p < S) { p0 = p0 + (f32x4){bflo(pw[p].x), bfhi(pw[p].x), bflo(pw[p].y), bfhi(pw[p].y)}; p1 = p1 + (f32x4){bflo(pw[p].z), bfhi(pw[p].z), bflo(pw[p].w), bfhi(pw[p].w)}; }
                    a0 = a0 + alpha * p0; a1 = a1 + alpha * p1;
                    v4u w; w.x = pk2(a0.x, a0.y); w.y = pk2(a0.z, a0.w); w.z = pk2(a1.x, a1.y); w.w = pk2(a1.z, a1.w);
                    ((GAS v4u*)(HB + (size_t)r * DM))[lane + 64 * j] = w;
                    a0 = (f32x4){bflo(w.x), bfhi(w.x), bflo(w.y), bfhi(w.y)}; a1 = (f32x4){bflo(w.z), bfhi(w.z), bflo(w.w), bfhi(w.w)};
                    v[j] = w;
                }
            }
            s += (a0.x * a0.x + a0.y * a0.y) + (a0.z * a0.z + a0.w * a0.w) + (a1.x * a1.x + a1.y * a1.y) + (a1.z * a1.z + a1.w * a1.w);
        }
        const float rinv = 1.0f / sqrtf(wave_sum(s) * (1.0f / 4096.0f) + EPSN);
#pragma unroll
        for (int j = 0; j < 8; ++j) {
            const f32x4 o0 = (f32x4){bflo(v[j].x), bfhi(v[j].x), bflo(v[j].y), bfhi(v[j].y)} * rinv * g0[j], o1 = (f32x4){bflo(v[j].z), bfhi(v[j].z), bflo(v[j].w), bfhi(v[j].w)} * rinv * g1[j];
            if (TO_BF16) { v4u w; w.x = pk2(o0.x, o0.y); w.y = pk2(o0.z, o0.w); w.z = pk2(o1.x, o1.y); w.w = pk2(o1.z, o1.w); ((GAS v4u*)(XNo + (size_t)r * DM))[lane + 64 * j] = w; }
            else { GAS f32x4* yp = (GAS f32x4*)(yout + (size_t)r * DM + 8 * (lane + 64 * j)); yp[0] = o0 * MK_YSCALE; yp[1] = o1 * MK_YSCALE; }
        }
#pragma unroll
        for (int j = 0; j < 8; ++j) v[j] = nx[j];
    }
#undef NH_LOAD
}
__device__ __forceinline__ void norm_phase_y(bf16* HB, const float* __restrict__ g, float* yout, int gw, int NGW, int lane, const LAS unsigned char* tab, const float* __restrict__ slabs, float alpha, int S) {
    f32x4 gg[16]; v2u v[16], nx[16];
#pragma unroll
    for (int jj = 0; jj < 16; ++jj) gg[jj] = *(const GAS f32x4*)(g + 256 * jj + 4 * lane);
#define NY_LOAD(dst, rr) do { const GAS v2u* hr_ = (const GAS v2u*)(HB + (size_t)(rr) * DM) + lane; _Pragma("unroll") for (int jj = 0; jj < 16; ++jj) dst[jj] = hr_[64 * jj]; } while (0)
    int r = gw;
    if (r < TT) NY_LOAD(v, r);
    for (; r < TT; r += NGW) {
        if (r + NGW < TT) NY_LOAD(nx, r + NGW);
        const int pm = r >> 8; float s = 0.f;
        const unsigned pmask = (unsigned)__builtin_amdgcn_readfirstlane((int)((const LAS unsigned short*)(tab + 1088))[pm]);
#pragma unroll
        for (int jj = 0; jj < 16; ++jj) {
            f32x4 a = (f32x4){bflo(v[jj].x), bfhi(v[jj].x), bflo(v[jj].y), bfhi(v[jj].y)};
            if ((pmask >> jj) & 1u) {
                const int slot = __builtin_amdgcn_readfirstlane((int)tab[pm * 16 + jj]);
                const GAS v2u* sp = (const GAS v2u*)((const bf16*)slabs + (size_t)slot * S * 65536 + (size_t)(r & 255) * 256 + 4 * lane);
                f32x4 ps = (f32x4){0.f, 0.f, 0.f, 0.f};
#pragma unroll
                for (int p = 0; p < 8; ++p) if (p < S) { const v2u w = sp[(size_t)p * 16384]; ps = ps + (f32x4){bflo(w.x), bfhi(w.x), bflo(w.y), bfhi(w.y)}; }
                a = a + alpha * ps;
                v2u w; w.x = pk2(a.x, a.y); w.y = pk2(a.z, a.w);
                ((GAS v2u*)(HB + (size_t)r * DM))[lane + 64 * jj] = w;
                a = (f32x4){bflo(w.x), bfhi(w.x), bflo(w.y), bfhi(w.y)}; v[jj] = w;
            }
            s += (a.x * a.x + a.y * a.y) + (a.z * a.z + a.w * a.w);
        }
        const float rinv = 1.0f / sqrtf(wave_sum(s) * (1.0f / 4096.0f) + EPSN);
#pragma unroll
        for (int jj = 0; jj < 16; ++jj) { const f32x4 o = (f32x4){bflo(v[jj].x), bfhi(v[jj].x), bflo(v[jj].y), bfhi(v[jj].y)} * rinv * gg[jj];
            __builtin_nontemporal_store(o * MK_YSCALE, (GAS f32x4*)(yout + (size_t)r * DM + 256 * jj + 4 * lane)); }
#pragma unroll
        for (int jj = 0; jj < 16; ++jj) v[jj] = nx[jj];
    }
#undef NY_LOAD
}
__device__ __forceinline__ int pos_of_row(int r) { return r < TP ? (r & (SEQ - 1)) : 1024 + ((r - TP) & 63); }
__device__ __forceinline__ int crow_of_row(int r) { return r < TP ? r : TP + 1088 * ((r - TP) >> 6) + 1024 + ((r - TP) & 63); }

typedef short v4i16_t __attribute__((ext_vector_type(4)));
__device__ __forceinline__ bf16x8 tr_frag(const LAS unsigned char* img, int stride, int row0, int col0, int li, int q4) {
    const LAS unsigned char* p = img + (row0 + 8 * q4 + (li >> 2)) * stride + (col0 + 4 * (li & 3)) * 2;
    const v4i16_t a = __builtin_amdgcn_ds_read_tr16_b64_v4i16((LAS v4i16_t*)p);
    const v4i16_t b = __builtin_amdgcn_ds_read_tr16_b64_v4i16((LAS v4i16_t*)(p + 4 * stride));
    bf16x8 r; r[0] = a[0]; r[1] = a[1]; r[2] = a[2]; r[3] = a[3]; r[4] = b[0]; r[5] = b[1]; r[6] = b[2]; r[7] = b[3]; return r;
}

constexpr int R_QS = 0, R_KS = 33792, R_VS = 67584, R_V2 = 84992, R_PS = 102400, R_QSTR = 528, R_VSTR = 272, R_PSTR = 144;
__device__ __forceinline__ void ret_unit(LAS unsigned char* lds, int kind, int bidx, int h, int half, const bf16* __restrict__ Z, bf16* OM, const float* __restrict__ S0, float* Sout, int tid) {
    const int wid = __builtin_amdgcn_readfirstlane(tid >> 6), lane = tid & 63, li = lane & 15, q4 = lane >> 4;
    const int nchunks = kind == 0 ? 128 : 1;
    const int row0 = kind == 0 ? bidx * SEQ : TP + 64 * bidx;
    const float lg = __builtin_log2f(1.0f - ex2(-5.0f - (float)h));
    const int cw = 128 * half + 16 * wid;
    f32x4 S[16];
    if (kind == 0) {
#pragma unroll
        for (int j = 0; j < 16; ++j) S[j] = (f32x4){0.f, 0.f, 0.f, 0.f};
    } else {
        const float* sp = S0 + ((size_t)(bidx * 8 + h) * 256) * 256 + cw + li;
#pragma unroll
        for (int j = 0; j < 16; ++j)
#pragma unroll
            for (int r = 0; r < 4; ++r) S[j][r] = sp[(size_t)(16 * j + 4 * q4 + r) * 256];
    }
    v4u rq[4], rk[4], rv[2];
    const int qrow = tid >> 5, qc = tid & 31, vrow = tid >> 4, vc = tid & 15;
#define RET_LOAD(c) do { const bf16* zb = Z + (size_t)(row0 + 64 * (c)) * ZLD + h * 256; \
        _Pragma("unroll") for (int i = 0; i < 4; ++i) { rq[i] = *(const GAS v4u*)(zb + (size_t)(qrow + 16 * i) * ZLD + 8 * qc); rk[i] = *(const GAS v4u*)(zb + (size_t)(qrow + 16 * i) * ZLD + 2048 + 8 * qc); } \
        _Pragma("unroll") for (int i = 0; i < 2; ++i) rv[i] = *(const GAS v4u*)(zb + (size_t)(vrow + 32 * i) * ZLD + 4096 + 128 * half + 8 * vc); } while (0)
    RET_LOAD(0);
    const float g64 = ex2(64.0f * lg);
    for (int c = 0; c < nchunks; ++c) {
        __syncthreads();
#pragma unroll
        for (int i = 0; i < 4; ++i) { *(LAS v4u*)(lds + R_QS + (qrow + 16 * i) * R_QSTR + 16 * qc) = rq[i]; *(LAS v4u*)(lds + R_KS + (qrow + 16 * i) * R_QSTR + 16 * qc) = rk[i]; }
#pragma unroll
        for (int i = 0; i < 2; ++i) { const int row = vrow + 32 * i; *(LAS v4u*)(lds + R_VS + row * R_VSTR + 16 * vc) = rv[i];
            const float sc = ex2((float)(63 - row) * lg); v4u w;
            w.x = pk2(bflo(rv[i].x) * sc, bfhi(rv[i].x) * sc); w.y = pk2(bflo(rv[i].y) * sc, bfhi(rv[i].y) * sc); w.z = pk2(bflo(rv[i].z) * sc, bfhi(rv[i].z) * sc); w.w = pk2(bflo(rv[i].w) * sc, bfhi(rv[i].w) * sc);
            *(LAS v4u*)(lds + R_V2 + row * R_VSTR + 16 * vc) = w; }
        __syncthreads();
        if (c + 1 < nchunks) RET_LOAD(c + 1);
        {
            const int bi = wid >> 1, bj0 = 2 * (wid & 1);
            f32x4 p0 = (f32x4){0.f, 0.f, 0.f, 0.f}, p1 = p0;
#pragma unroll
            for (int ks = 0; ks < 8; ++ks) {
                const bf16x8 a = *(const LAS bf16x8*)(lds + R_QS + (16 * bi + li) * R_QSTR + (32 * ks + 8 * q4) * 2);
                const bf16x8 b0 = *(const LAS bf16x8*)(lds + R_KS + (16 * bj0 + li) * R_QSTR + (32 * ks + 8 * q4) * 2);
                const bf16x8 b1 = *(const LAS bf16x8*)(lds + R_KS + (16 * bj0 + 16 + li) * R_QSTR + (32 * ks + 8 * q4) * 2);
                p0 = __builtin_amdgcn_mfma_f32_16x16x32_bf16(a, b0, p0, 0, 0, 0);
                p1 = __builtin_amdgcn_mfma_f32_16x16x32_bf16(a, b1, p1, 0, 0, 0);
            }
#pragma unroll
            for (int r = 0; r < 4; ++r) { const int l = 16 * bi + 4 * q4 + r, m0 = 16 * bj0 + li, m1 = m0 + 16;
                const float v0 = (l >= m0) ? p0[r] * ex2((float)(l - m0) * lg) : 0.f, v1 = (l >= m1) ? p1[r] * ex2((float)(l - m1) * lg) : 0.f;
                *(LAS unsigned short*)(lds + R_PS + l * R_PSTR + m0 * 2) = (unsigned short)f2bf(v0);
                *(LAS unsigned short*)(lds + R_PS + l * R_PSTR + m1 * 2) = (unsigned short)f2bf(v1); }
        }
        __syncthreads();
        {
            f32x4 o[4];
#pragma unroll
            for (int tb = 0; tb < 4; ++tb) o[tb] = (f32x4){0.f, 0.f, 0.f, 0.f};
#pragma unroll
            for (int ks = 0; ks < 8; ++ks) {
                v4u sw; sw.x = pk2(S[2 * ks][0], S[2 * ks][1]); sw.y = pk2(S[2 * ks][2], S[2 * ks][3]); sw.z = pk2(S[2 * ks + 1][0], S[2 * ks + 1][1]); sw.w = pk2(S[2 * ks + 1][2], S[2 * ks + 1][3]);
                const bf16x8 sb = __builtin_bit_cast(bf16x8, sw);
#pragma unroll
                for (int tb = 0; tb < 4; ++tb) {
                    const v2u lo = *(const LAS v2u*)(lds + R_QS + (16 * tb + li) * R_QSTR + (32 * ks + 4 * q4) * 2);
                    const v2u hi = *(const LAS v2u*)(lds + R_QS + (16 * tb + li) * R_QSTR + (32 * ks + 16 + 4 * q4) * 2);
                    v4u w; w.x = lo.x; w.y = lo.y; w.z = hi.x; w.w = hi.y;
                    o[tb] = __builtin_amdgcn_mfma_f32_16x16x32_bf16(sb, __builtin_bit_cast(bf16x8, w), o[tb], 0, 0, 0);
                }
            }
            const bf16x8 vf0 = tr_frag(lds + R_VS, R_VSTR, 0, 16 * wid, li, q4), vf1 = tr_frag(lds + R_VS, R_VSTR, 32, 16 * wid, li, q4);
#pragma unroll
            for (int tb = 0; tb < 4; ++tb) {
                o[tb] = o[tb] * ex2((float)(16 * tb + li + 1) * lg);
                const bf16x8 pa0 = *(const LAS bf16x8*)(lds + R_PS + (16 * tb + li) * R_PSTR + (8 * q4) * 2);
                const bf16x8 pa1 = *(const LAS bf16x8*)(lds + R_PS + (16 * tb + li) * R_PSTR + (32 + 8 * q4) * 2);
                o[tb] = __builtin_amdgcn_mfma_f32_16x16x32_bf16(vf0, pa0, o[tb], 0, 0, 0);
                o[tb] = __builtin_amdgcn_mfma_f32_16x16x32_bf16(vf1, pa1, o[tb], 0, 0, 0);
                v2u ow; ow.x = pk2(o[tb][0], o[tb][1]); ow.y = pk2(o[tb][2], o[tb][3]);
                *(GAS v2u*)(OM + (size_t)(row0 + 64 * c + 16 * tb + li) * DM + h * 256 + cw + 4 * q4) = ow;
            }
        }
        {
            const bf16x8 wf0 = tr_frag(lds + R_V2, R_VSTR, 0, 16 * wid, li, q4), wf1 = tr_frag(lds + R_V2, R_VSTR, 32, 16 * wid, li, q4);
#pragma unroll
            for (int j = 0; j < 16; ++j) {
                S[j] = S[j] * g64;
                const bf16x8 k0 = tr_frag(lds + R_KS, R_QSTR, 0, 16 * j, li, q4), k1 = tr_frag(lds + R_KS, R_QSTR, 32, 16 * j, li, q4);
                S[j] = __builtin_amdgcn_mfma_f32_16x16x32_bf16(k0, wf0, S[j], 0, 0, 0);
                S[j] = __builtin_amdgcn_mfma_f32_16x16x32_bf16(k1, wf1, S[j], 0, 0, 0);
            }
        }
    }
#undef RET_LOAD
    float* so = Sout + cw + li;
#pragma unroll
    for (int j = 0; j < 16; ++j)
#pragma unroll
        for (int r = 0; r < 4; ++r) so[(size_t)(16 * j + 4 * q4 + r) * 256] = S[j][r];
}

constexpr int A_NSTR = 272, A_RSTR = 144, A_VSTR = 144, A_KN = 64 * A_NSTR  , A_KR = 64 * A_RSTR  , A_KB = A_KN + A_KR  , A_VB = 128 * A_VSTR  , A_V0 = 3 * A_KB;
constexpr int A_NI_N = 17, A_NI_R = 9, A_NI_V = 18, A_NI = A_NI_N + A_NI_R + A_NI_V;
static_assert(A_KN == A_NI_N * 1024 && A_KR == A_NI_R * 1024 && A_VB == A_NI_V * 1024 && A_V0 + 2 * A_VB <= RING_BYTES, "attention LDS map");
__device__ __forceinline__ void attn_qk(f32x16& p, const LAS unsigned char* kb, int half, const bf16x8 (&q)[12], int n32, int hi) {
#pragma unroll
    for (int r = 0; r < 16; ++r) p[r] = 0.f;
    bf16x8 a[12];
#pragma unroll
    for (int ks = 0; ks < 8; ++ks) a[ks] = *(const LAS bf16x8*)(kb + (32 * half + n32) * A_NSTR + (16 * ks + 8 * hi) * 2);
#pragma unroll
    for (int ks = 0; ks < 4; ++ks) a[8 + ks] = *(const LAS bf16x8*)(kb + A_KN + (32 * half + n32) * A_RSTR + (16 * ks + 8 * hi) * 2);
#pragma unroll
    for (int ks = 0; ks < 12; ++ks) p = __builtin_amdgcn_mfma_f32_32x32x16_bf16(a[ks], q[ks], p, 0, 0, 0);
}
__device__ __forceinline__ float attn_softmax(f32x16& p, float& m_run, float& l_run, bf16x8 (&pa)[2]) {
    float pmax = p[0];
#pragma unroll
    for (int r = 1; r < 16; ++r) pmax = fmaxf(pmax, p[r]);
    { auto rr = __builtin_amdgcn_permlane32_swap(__float_as_uint(pmax), __float_as_uint(pmax), false, false); pmax = fmaxf(__uint_as_float(rr[0]), __uint_as_float(rr[1])); }
    const bool need = (pmax - m_run) > 10.0f;
    const float mn = need ? pmax : m_run, alpha = ex2(m_run - mn); m_run = mn;
    float ps = 0.f;
#pragma unroll
    for (int r = 0; r < 16; ++r) { p[r] = ex2(p[r] - mn); ps += p[r]; }
    { auto rr = __builtin_amdgcn_permlane32_swap(__float_as_uint(ps), __float_as_uint(ps), false, false); ps = __uint_as_float(rr[0]) + __uint_as_float(rr[1]); }
    l_run = l_run * alpha + ps;
#define PK4(P, B_, OUT) do { const unsigned a0_ = pk2(P[B_ + 0], P[B_ + 1]), a1_ = pk2(P[B_ + 2], P[B_ + 3]), b0_ = pk2(P[B_ + 4], P[B_ + 5]), b1_ = pk2(P[B_ + 6], P[B_ + 7]); \
    auto r0_ = __builtin_amdgcn_permlane32_swap(a0_, b0_, false, false); auto r1_ = __builtin_amdgcn_permlane32_swap(a1_, b1_, false, false); \
    v4u w_; w_.x = r0_[0]; w_.y = r1_[0]; w_.z = r0_[1]; w_.w = r1_[1]; OUT = __builtin_bit_cast(bf16x8, w_); } while (0)
    PK4(p, 0, pa[0]); PK4(p, 8, pa[1]);
#undef PK4
    return alpha;
}
__device__ __forceinline__ void attn_pv(f32x16 (&O)[4], const LAS unsigned char* vbh  , const bf16x8 (&pa)[2], float alpha, int n32, int hi) {
    if (__any(alpha != 1.0f)) {
#pragma unroll
        for (int cb = 0; cb < 4; ++cb)
#pragma unroll
            for (int r = 0; r < 16; ++r) O[cb][r] *= alpha;
    }
    bf16x8 v[4][2];
#pragma unroll
    for (int cb = 0; cb < 4; ++cb)
#pragma unroll
        for (int ks = 0; ks < 2; ++ks) v[cb][ks] = *(const LAS bf16x8*)(vbh + (32 * cb + n32) * A_VSTR + (16 * ks + 8 * hi) * 2);
#pragma unroll
    for (int ks = 0; ks < 2; ++ks)
#pragma unroll
        for (int cb = 0; cb < 4; ++cb) O[cb] = __builtin_amdgcn_mfma_f32_32x32x16_bf16(v[cb][ks], pa[ks], O[cb], 0, 0, 0);
}
#define ATT_SCHED() do { __builtin_amdgcn_sched_group_barrier(0x100, 12, 0); _Pragma("unroll") for (int i_ = 0; i_ < 12; ++i_) { __builtin_amdgcn_sched_group_barrier(0x008, 1, 0); __builtin_amdgcn_sched_group_barrier(0x002, 9, 0); } } while (0)
__device__ __forceinline__ void attn_unit(LAS unsigned char* lds, int qrow0, int nqw, int krow0, int ntiles, int wt_base, int h,
                                          const bf16* __restrict__ QH, const bf16* __restrict__ KN, const bf16* __restrict__ KR, const bf16* __restrict__ VT, bf16* OM, int tid,
                                          const float* __restrict__ gqn, const float* __restrict__ gqr, const float* __restrict__ mcos, const float* __restrict__ msin) {
    const int wid = __builtin_amdgcn_readfirstlane(tid >> 6), lane = tid & 63, n32 = lane & 31, hi = lane >> 5;
    const bool active = wid < nqw;
    const int my_tiles = !active ? 0 : (wt_base < 0 ? ntiles : wt_base + (wid >> 1) + 1);
    f32x16 O[4];
#pragma unroll
    for (int cb = 0; cb < 4; ++cb)
#pragma unroll
        for (int r = 0; r < 16; ++r) O[cb][r] = 0.f;
    float m_run = -1e30f, l_run = 0.f;
    unsigned doff[6];
#pragma unroll
    for (int k = 0; k < 6; ++k) { const int sl = wid + 8 * k;
        if (sl < A_NI_N) { const int pp = 64 * sl + lane, row = pp / 17, c = pp - 17 * row; doff[k] = (unsigned)(row * (KNLD * 2) + h * 256 + (c < 16 ? c : 15) * 16); }
        else if (sl < A_NI_N + A_NI_R) { const int pp = 64 * (sl - A_NI_N) + lane, row = pp / 9, c = pp - 9 * row; doff[k] = (unsigned)(row * 128 + (c < 8 ? c : 7) * 16); }
        else { const int pp = 64 * (sl - A_NI_N - A_NI_R) + lane, row = pp / 9, c = pp - 9 * row; doff[k] = (unsigned)((h * 128 + row) * (KROWS * 2) + (c < 8 ? c : 7) * 16); } }
    const int tlast = ntiles - 1;
#define ATT_DMA_K(t, kbi) do { const int jj_ = (t) < tlast ? (t) : tlast; const size_t kr0_ = (size_t)krow0 + 64 * (size_t)jj_; \
        _Pragma("unroll") for (int k = 0; k < 4; ++k) { const int sl = wid + 8 * k; \
            if (sl < A_NI_N) __builtin_amdgcn_global_load_lds((const unsigned*)((const char*)KN + kr0_ * (KNLD * 2) + doff[k]), (LAS unsigned*)(lds + (kbi) * A_KB + sl * 1024), 16, 0, 0); \
            else if (sl < A_NI_N + A_NI_R) __builtin_amdgcn_global_load_lds((const unsigned*)((const char*)KR + kr0_ * 128 + doff[k]), (LAS unsigned*)(lds + (kbi) * A_KB + A_KN + (sl - A_NI_N) * 1024), 16, 0, 0); } } while (0)
#define ATT_DMA_V(t, vbi) do { const int jj_ = (t) < tlast ? (t) : tlast; const size_t kr0_ = (size_t)krow0 + 64 * (size_t)jj_; \
        _Pragma("unroll") for (int k = 3; k < 6; ++k) { const int sl = wid + 8 * k; \
            if (sl >= A_NI_N + A_NI_R && sl < A_NI) __builtin_amdgcn_global_load_lds((const unsigned*)((const char*)VT + kr0_ * 2 + doff[k]), (LAS unsigned*)(lds + A_V0 + (vbi) * A_VB + (sl - A_NI_N - A_NI_R) * 1024), 16, 0, 0); } } while (0)
    __syncthreads();
    ATT_DMA_K(0, 0); ATT_DMA_V(0, 0); ATT_DMA_K(1, 1);
    bf16x8 q[12];
    {
        const int qrow = qrow0 + 32 * (active ? wid : 0) + n32;
        const bf16* qp = QH + (size_t)qrow * QLD + h * 192 + 8 * hi;
        v4u qv[12];
#pragma unroll
        for (int ks = 0; ks < 12; ++ks) qv[ks] = *(const GAS v4u*)(qp + 16 * ks);
        float sn = 0.f, sr = 0.f;
#pragma unroll
        for (int ks = 0; ks < 12; ++ks) { const float a0 = bflo(qv[ks].x), a1 = bfhi(qv[ks].x), a2 = bflo(qv[ks].y), a3 = bfhi(qv[ks].y), a4 = bflo(qv[ks].z), a5 = bfhi(qv[ks].z), a6 = bflo(qv[ks].w), a7 = bfhi(qv[ks].w);
            const float t = (a0 * a0 + a1 * a1) + (a2 * a2 + a3 * a3) + (a4 * a4 + a5 * a5) + (a6 * a6 + a7 * a7); if (ks < 8) sn += t; else sr += t; }
        sn += __shfl_xor(sn, 32); sr += __shfl_xor(sr, 32);
        const float rn = QSCALE / sqrtf(sn * (1.0f / 128.0f) + EPSN), rr = 1.0f / sqrtf(sr * (1.0f / 64.0f) + EPSN);
#pragma unroll
        for (int ks = 0; ks < 8; ++ks) { const GAS f32x4* gp = (const GAS f32x4*)(gqn + 16 * ks + 8 * hi); const f32x4 ga = gp[0], gb = gp[1]; const v4u r = qv[ks]; v4u w;
            w.x = pk2(bflo(r.x) * rn * ga.x, bfhi(r.x) * rn * ga.y); w.y = pk2(bflo(r.y) * rn * ga.z, bfhi(r.y) * rn * ga.w);
            w.z = pk2(bflo(r.z) * rn * gb.x, bfhi(r.z) * rn * gb.y); w.w = pk2(bflo(r.w) * rn * gb.z, bfhi(r.w) * rn * gb.w); qv[ks] = w; asm volatile("" : "+v"(qv[ks])); }
        const int pos = pos_of_row(qrow);
#pragma unroll
        for (int kk = 0; kk < 2; ++kk) {
            const int d0 = 16 * kk + 8 * hi;
            const GAS float* g1p = (const GAS float*)(gqr + d0); const GAS float* g2p = (const GAS float*)(gqr + 32 + d0);
            const GAS float* cp = (const GAS float*)(mcos + pos * 32 + d0); const GAS float* sp = (const GAS float*)(msin + pos * 32 + d0);
            const v4u r1 = qv[8 + kk], r2 = qv[10 + kk]; unsigned w1[4], w2[4];
            const unsigned r1a[4] = {r1.x, r1.y, r1.z, r1.w}, r2a[4] = {r2.x, r2.y, r2.z, r2.w};
#pragma unroll
            for (int i = 0; i < 4; ++i) {
                const float ya = bflo(r1a[i]) * rr * g1p[2 * i], yb = bfhi(r1a[i]) * rr * g1p[2 * i + 1], za = bflo(r2a[i]) * rr * g2p[2 * i], zb = bfhi(r2a[i]) * rr * g2p[2 * i + 1];
                const float ca = cp[2 * i], cb = cp[2 * i + 1], sa = sp[2 * i], sb = sp[2 * i + 1];
                w1[i] = pk2((ya * ca - za * sa) * QSCALE, (yb * cb - zb * sb) * QSCALE); w2[i] = pk2((za * ca + ya * sa) * QSCALE, (zb * cb + yb * sb) * QSCALE); }
            qv[8 + kk] = (v4u){w1[0], w1[1], w1[2], w1[3]}; qv[10 + kk] = (v4u){w2[0], w2[1], w2[2], w2[3]};
        }
#pragma unroll
        for (int ks = 0; ks < 12; ++ks) q[ks] = __builtin_bit_cast(bf16x8, qv[ks]);
    }
    __builtin_amdgcn_sched_barrier(0);
    VM_WAIT(); __syncthreads();
    f32x16 p;
    if (wid >= 4) __builtin_amdgcn_s_setprio(1);
    if (0 < my_tiles) attn_qk(p, lds, 0, q, n32, hi);
    int j = 0, kc = 0;
    for (; j + 1 < my_tiles; ++j) {
        const int k1 = kc == 2 ? 0 : kc + 1, k2 = k1 == 2 ? 0 : k1 + 1;
        ATT_DMA_K(j + 2, k2); ATT_DMA_V(j + 1, (j + 1) & 1);
        const LAS unsigned char* kb = lds + kc * A_KB; const LAS unsigned char* kn = lds + k1 * A_KB; const LAS unsigned char* vb = lds + A_V0 + (j & 1) * A_VB;
        { f32x16 n; bf16x8 pa[2];
          attn_qk(n, kb, 1, q, n32, hi);
          const float alpha = attn_softmax(p, m_run, l_run, pa);
          ATT_SCHED();
          attn_pv(O, vb, pa, alpha, n32, hi);
          p = n; }
        { f32x16 n; bf16x8 pa[2];
          attn_qk(n, kn, 0, q, n32, hi);
          const float alpha = attn_softmax(p, m_run, l_run, pa);
          ATT_SCHED();
          attn_pv(O, vb + 64, pa, alpha, n32, hi);
          p = n; }
        VM_WAIT(); __syncthreads();
        kc = k1;
    }
    if (j < my_tiles) {
        const int k1 = kc == 2 ? 0 : kc + 1, k2 = k1 == 2 ? 0 : k1 + 1;
        ATT_DMA_K(j + 2, k2); ATT_DMA_V(j + 1, (j + 1) & 1);
        const LAS unsigned char* kb = lds + kc * A_KB; const LAS unsigned char* vb = lds + A_V0 + (j & 1) * A_VB;
        { f32x16 n; bf16x8 pa[2];
          attn_qk(n, kb, 1, q, n32, hi);
          const float alpha = attn_softmax(p, m_run, l_run, pa);
          ATT_SCHED();
          attn_pv(O, vb, pa, alpha, n32, hi);
          p = n; }
        { bf16x8 pa[2];
          const float alpha = attn_softmax(p, m_run, l_run, pa);
          attn_pv(O, vb + 64, pa, alpha, n32, hi); }
        VM_WAIT(); __syncthreads();
        kc = k1; ++j;
    }
    for (; j < ntiles; ++j) {
        const int k1 = kc == 2 ? 0 : kc + 1, k2 = k1 == 2 ? 0 : k1 + 1;
        ATT_DMA_K(j + 2, k2); ATT_DMA_V(j + 1, (j + 1) & 1);
        VM_WAIT(); __syncthreads();
        kc = k1;
    }
#undef ATT_DMA_K
#undef ATT_DMA_V
    __builtin_amdgcn_s_setprio(0);
    if (active) {
        const float il = 1.0f / l_run;
        unsigned char* orow = (unsigned char*)(OM + (size_t)(qrow0 + 32 * wid + n32) * DM + 2048 + h * 128) + (hi ? 16 : 0);
#pragma unroll
        for (int k = 0; k < 16; k += 2) { const int cb = k >> 2, g = k & 3;
            unsigned ax = pk2(O[cb][4 * g] * il, O[cb][4 * g + 1] * il), ay = pk2(O[cb][4 * g + 2] * il, O[cb][4 * g + 3] * il);
            unsigned bx = pk2(O[cb][4 * g + 4] * il, O[cb][4 * g + 5] * il), by = pk2(O[cb][4 * g + 6] * il, O[cb][4 * g + 7] * il);
            { auto r = __builtin_amdgcn_permlane32_swap(ax, bx, false, false); ax = r[0]; bx = r[1]; }
            { auto r = __builtin_amdgcn_permlane32_swap(ay, by, false, false); ay = r[0]; by = r[1]; }
            *(GAS v4u*)(orow + 16 * k) = (v4u){ax, ay, bx, by}; }
    }
}

constexpr int NWAVES = 8;
constexpr int N_PHASES = 15;
struct Args { const float* in[26]; float* out; unsigned char* ws; int ph_lo, ph_hi, li, pad1; };
__global__ void __launch_bounds__(NWAVES * 64, 2) mk_fwd(Args args) {
    extern __shared__ __attribute__((aligned(16))) unsigned char lds_raw[];
    LAS unsigned char* lds = (LAS unsigned char*)lds_raw;
    volatile LAS unsigned* MISC = (volatile LAS unsigned*)(lds + MISC_OFF);
    const int tid = threadIdx.x, lane = tid & 63, wave = __builtin_amdgcn_readfirstlane(tid >> 6);
    const int G = gridDim.x;
    const int gw = blockIdx.x * NWAVES + wave, NGW = G * NWAVES;
    unsigned char* ws = args.ws;
    unsigned* ctl = (unsigned*)(ws + WS_CTL);
    float* out = args.out;
    bf16* W1GU = (bf16*)(ws + WS_W1GU); bf16* W1D = (bf16*)(ws + WS_W1D); bf16* W2GU = (bf16*)(ws + WS_W2GU); bf16* W2D = (bf16*)(ws + WS_W2D);
    bf16* WIN = (bf16*)(ws + WS_WIN); bf16* WUQ = (bf16*)(ws + WS_WUQ); bf16* WUK = (bf16*)(ws + WS_WUK); bf16* WUV = (bf16*)(ws + WS_WUV); bf16* WOUT = (bf16*)(ws + WS_WOUT);
    bf16* XN = (bf16*)(ws + WS_XN); bf16* HID = (bf16*)(ws + WS_HID); bf16* Z = (bf16*)(ws + WS_Z); bf16* QAN = (bf16*)(ws + WS_QAN); bf16* QH = (bf16*)(ws + WS_QH);
    bf16* CALL = (bf16*)(ws + WS_CALL); bf16* KRA = (bf16*)(ws + WS_KR); bf16* KN = (bf16*)(ws + WS_KN); bf16* VT = (bf16*)(ws + WS_VT);
    float* slabs = (float*)(ws + WS_SLAB); bf16* HB = (bf16*)(ws + WS_HB);
    float* rcos = (float*)(ws + WS_TAB); float* rsin = rcos + 8192 * 128; float* mcos = rsin + 8192 * 128; float* msin = mcos + 8192 * 32;

    for (int u = tid; u < (LDS_BYTES - RING_BYTES) / 4; u += NWAVES * 64) ((LAS unsigned*)(lds + RING_BYTES))[u] = 0u;
    __syncthreads();
    volatile LAS unsigned* ARGP = (volatile LAS unsigned*)(lds + MISC_OFF + 256);
    if (tid < 26) { const unsigned long long pv = (unsigned long long)args.in[tid]; ARGP[2 * tid] = (unsigned)pv; ARGP[2 * tid + 1] = (unsigned)(pv >> 32); }
    __syncthreads();
#define ARGIN(k) ((const float*)(((unsigned long long)(unsigned)__builtin_amdgcn_readfirstlane((int)ARGP[2 * (k) + 1]) << 32) | (unsigned long long)(unsigned)__builtin_amdgcn_readfirstlane((int)ARGP[2 * (k)])))
    XcdBarrier bar = xcd_barrier_post(ctl + CW_BAR + args.li * XCD_BAR_WORDS, MISC + 8);
    const int lo = args.ph_lo, hi = args.ph_hi;
#ifndef MK_PHASE_MASK
#define MK_PHASE_MASK 0x7fff
#endif
#define IN(k) ((((MK_PHASE_MASK) >> (k)) & 1) && lo <= (k) && (k) < hi)
#define NEXTP(k) ((k) == 6 ? 8 : (k) + 1)
#define SEAM(k) do { if (IN(k) && IN(NEXTP(k))) xcd_barrier(bar); } while (0)

    constexpr int BGQ_B0 = (DM / 64) * (DIN / 32), BGQ_B1 = BGQ_B0 + 16 * 96, BGQ_B2 = BGQ_B1 + 8 * 128, BGQ_B3 = BGQ_B2 + 64 * 128, BGQ_B4 = BGQ_B3 + 64 * (DFF / 32), BGQ_B5 = BGQ_B4 + 64 * (DFF / 32), BGQ_B6 = BGQ_B5 + (DFF / 64) * 128, BGQ_B7 = BGQ_B6 + (DFF / 64) * 128;
    static_assert(BGQ_B0 % 64 == 0 && BGQ_B1 % 64 == 0 && BGQ_B2 % 64 == 0 && BGQ_B3 % 64 == 0 && BGQ_B4 % 64 == 0 && BGQ_B5 % 64 == 0 && BGQ_B6 % 64 == 0 && BGQ_B7 % 64 == 0, "a chunk of 64 items never straddles two matrices");
#define BG_DRAIN(ctr_, it_lo_, it_hi_) do { \
        for (;;) { \
            if (tid == 0) MISC[0] = __hip_atomic_fetch_add((ctr_), 1u, __ATOMIC_RELAXED, __HIP_MEMORY_SCOPE_AGENT); \
            __syncthreads(); \
            const int ch_ = (int)__builtin_amdgcn_readfirstlane(MISC[0]); \
            __syncthreads(); \
            const int it0 = (it_lo_) + ch_ * 64; if (it0 >= (it_hi_)) break; \
            _Pragma("unroll 1") \
            for (int q = 0; q < 8; q += 4) { const int it = it0 + wave * 8 + q; \
                if (it0 < BGQ_B0) convert_items4(ARGIN(10), DM, DIN, 0, WIN, nullptr, scr, it, lane); \
                else if (it0 < BGQ_B1) convert_items4(ARGIN(13), 1024, 3072, 0, WUQ, nullptr, scr, it - BGQ_B0, lane); \
                else if (it0 < BGQ_B2) convert_items4(ARGIN(18), 512, 4096, 3, WUK, WUV, scr, it - BGQ_B1, lane); \
                else if (it0 < BGQ_B3) convert_items4(ARGIN(20), DM, DM, 0, WOUT, nullptr, scr, it - BGQ_B2, lane); \
                else if (it0 < BGQ_B4) convert_items4(ARGIN(22), DM, DFF, 1, W2GU, nullptr, scr, it - BGQ_B3, lane); \
                else if (it0 < BGQ_B5) convert_items4(ARGIN(23), DM, DFF, 2, W2GU, nullptr, scr, it - BGQ_B4, lane); \
                else if (it0 < BGQ_B6) convert_items4(ARGIN(24), DFF, DM, 0, W2D, nullptr, scr, it - BGQ_B5, lane); \
                else convert_items4(ARGIN(8), DFF, DM, 0, W1D, nullptr, scr, it - BGQ_B6, lane); } \
        } } while (0)

#define P0_MISC(gt, NGT) do { const float* x_p = ARGIN(0); const float* x_s = ARGIN(1); \
        for (int i = gt; i < (ZLD - DIN) * DM / 8; i += NGT) ((GAS v4u*)(WIN + (size_t)DIN * DM))[i] = (v4u){0u, 0u, 0u, 0u}; \
        for (int i = gt; i < 8192 * 128; i += NGT) { float c, s; sincos_tab(i >> 7, i & 127, 128, c, s); rcos[i] = c; rsin[i] = s; } \
        for (int i = gt; i < 8192 * 32; i += NGT) { float c, s; sincos_tab(i >> 5, i & 31, 32, c, s); mcos[i] = c; msin[i] = s; } \
        for (int i = gt; i < 8 * 1024 * 512 / 8; i += NGT) { const int e = i * 8, sb = e / (1024 * 512), rem = e - sb * 1024 * 512, p = rem >> 9, c = rem & 511; \
            const f32x4 a = *(const GAS f32x4*)(ARGIN(3) + e), b = *(const GAS f32x4*)(ARGIN(3) + e + 4); \
            v4u w; w.x = pk2(a.x, a.y); w.y = pk2(a.z, a.w); w.z = pk2(b.x, b.y); w.w = pk2(b.z, b.w); \
            *(GAS v4u*)(CALL + (size_t)(TP + 1088 * sb + p) * 512 + c) = w; } \
        for (int i = gt; i < 8 * 1024 * 64 / 8; i += NGT) { const int e = i * 8, sb = e / (1024 * 64), rem = e - sb * 1024 * 64, p = rem >> 6, c = rem & 63; \
            const f32x4 a = *(const GAS f32x4*)(ARGIN(4) + e), b = *(const GAS f32x4*)(ARGIN(4) + e + 4); \
            v4u w; w.x = pk2(a.x, a.y); w.y = pk2(a.z, a.w); w.z = pk2(b.x, b.y); w.w = pk2(b.z, b.w); \
            *(GAS v4u*)(KRA + (size_t)(TP + 1088 * sb + p) * 64 + c) = w; } \
        {  \
            pg8::SplitTailOrder S; S.init(TT, DM, G, 0, DFF); S.wgm = MK_WGM_DOWN; const int R = S.nwg / G, rem = S.nwg - R * G; \
            for (int e = gt; e < rem * 16384; e += NGT) { const int tl = e >> 14, w = e & 16383, row = w >> 6, c4 = w & 63; pg8::Unit u; S.tile(R * G + tl, u); \
                const int r = u.pm * 256 + row; const float* src = (r < TP ? x_p + (size_t)r * DM : x_s + (size_t)(r - TP) * DM) + u.pn * 256 + 4 * c4; \
                const f32x4 xv = *(const GAS f32x4*)src; v2u hw; hw.x = pk2(xv.x, xv.y); hw.y = pk2(xv.z, xv.w); *(GAS v2u*)(HB + (size_t)r * DM + u.pn * 256 + 4 * c4) = hw; } } \
    } while (0)
    if (IN(0)) {
        const float* x_p = ARGIN(0); const float* x_s = ARGIN(1);
        LAS float* scr = (LAS float*)(lds + wave * 16384);
        convert_weight(ARGIN(6), DM, DFF, 1, W1GU, nullptr, scr, gw, NGW, lane);
        convert_weight(ARGIN(7), DM, DFF, 2, W1GU, nullptr, scr, gw, NGW, lane);
        if (G <= 248) { const int gt = blockIdx.x * (NWAVES * 64) + tid, NGT = G * NWAVES * 64; P0_MISC(gt, NGT); }
        norm_phase<false, true>(x_p, x_s, ARGIN(5), XN, nullptr, gw, NGW, lane, nullptr, nullptr, 0.f);
    }
    SEAM(0);
    if (IN(1)) {
        constexpr int GG = 248;
        const bool bg_only = G > GG && (int)blockIdx.x >= GG;
        if (!bg_only) { pg8::Gemm g{XN, W1GU, TT, 2 * DFF, DM}; pg8::StaticOrder S; S.init(TT, 2 * DFF, G > GG ? GG : G, (int)blockIdx.x, DM); pg8::EpiSwiGLU E{HID, DFF};
            pg8::gemm_phase<pg8::EpiSwiGLU, pg8::StaticOrder, true, true>(lds, g, S, E); }
        LAS float* scr = (LAS float*)(lds + wave * 16384);
        if (bg_only) { const int gt = ((int)blockIdx.x - GG) * (NWAVES * 64) + tid, NGT = (G - GG) * NWAVES * 64; P0_MISC(gt, NGT); }
        BG_DRAIN(ctl + CW_BGQ + 256 + 64 * args.li, BGQ_B6, BGQ_B7);
        BG_DRAIN(ctl + CW_BGQ + 64 * args.li, 0, (G == 256) ? BGQ_B2 : BGQ_B6);
    }
    SEAM(1);
    if (IN(2)) { pg8::Gemm g{HID, W1D, TT, DM, DFF}; pg8::SplitTailOrder S; S.init(TT, DM, G, (int)blockIdx.x, DFF); S.wgm = MK_WGM_DOWN; pg8::EpiResid<false> E{ARGIN(0), ARGIN(1), TP / 256, HB, DM, 0.5f, DFF / 64, slabs};
        pg8::gemm_phase<pg8::EpiResid<false>, pg8::SplitTailOrder, true, true>(lds, g, S, E); }
    SEAM(2);
    if (IN(3)) { LAS unsigned char* tab = lds; build_split_tab(tab, G, DFF, tid, MK_WGM_DOWN);
        norm_phase_h<true>(HB, ARGIN(9), XN, nullptr, gw, NGW, lane, tab, slabs, 0.5f, 8); }
    SEAM(3);
    if (IN(4)) { pg8::Gemm g{XN, WIN, TT, ZLD, DM}; pg8::WinOrder S; S.init(TT, ZLD, G, (int)blockIdx.x, DM); S.r0 = 0; S.r1 = (G == 256) ? 10 : (1 << 20); pg8::EpiZ E{Z, ZLD, rcos, rsin};
        pg8::gemm_phase<pg8::EpiZ, pg8::WinOrder, true, true>(lds, g, S, E); }
    SEAM(4);
    if (IN(5)) {
        const float* gqa = ARGIN(12); const float* gkva = ARGIN(16);
        const f32x4 gq0 = *(const GAS f32x4*)(gqa + 8 * lane), gq1 = *(const GAS f32x4*)(gqa + 8 * lane + 4), gq2 = *(const GAS f32x4*)(gqa + 512 + 8 * lane), gq3 = *(const GAS f32x4*)(gqa + 512 + 8 * lane + 4);
        const f32x4 gk0 = *(const GAS f32x4*)(gkva + 8 * lane), gk1 = *(const GAS f32x4*)(gkva + 8 * lane + 4);
        const float gkr = ARGIN(17)[lane];
        v4u nqa, nqb, nkv; unsigned nkr = 0u; float ncs = 0.f, nsn = 0.f;
#define P5_LOAD(rr) do { const bf16* zr_ = Z + (size_t)(rr) * ZLD + 8192; nqa = *(const GAS v4u*)(zr_ + 8 * lane); nqb = *(const GAS v4u*)(zr_ + 512 + 8 * lane); nkv = *(const GAS v4u*)(zr_ + 1024 + 8 * lane); nkr = (unsigned)zr_[1536 + lane]; \
        const int pp_ = pos_of_row(rr); ncs = mcos[pp_ * 32 + (lane & 31)]; nsn = msin[pp_ * 32 + (lane & 31)]; } while (0)
        if (gw < TT) P5_LOAD(gw);
        for (int r = gw; r < TT; r += NGW) {
            const v4u qa = nqa, qb = nqb, kv = nkv; const float kr = bflo(nkr), c = ncs, sn = nsn;
            if (r + NGW < TT) P5_LOAD(r + NGW);
            float q[16], c8[8];
            q[0] = bflo(qa.x); q[1] = bfhi(qa.x); q[2] = bflo(qa.y); q[3] = bfhi(qa.y); q[4] = bflo(qa.z); q[5] = bfhi(qa.z); q[6] = bflo(qa.w); q[7] = bfhi(qa.w);
            q[8] = bflo(qb.x); q[9] = bfhi(qb.x); q[10] = bflo(qb.y); q[11] = bfhi(qb.y); q[12] = bflo(qb.z); q[13] = bfhi(qb.z); q[14] = bflo(qb.w); q[15] = bfhi(qb.w);
            c8[0] = bflo(kv.x); c8[1] = bfhi(kv.x); c8[2] = bflo(kv.y); c8[3] = bfhi(kv.y); c8[4] = bflo(kv.z); c8[5] = bfhi(kv.z); c8[6] = bflo(kv.w); c8[7] = bfhi(kv.w);
            float sq = 0.f, sc = 0.f;
#pragma unroll
            for (int i = 0; i < 16; ++i) sq += q[i] * q[i];
#pragma unroll
            for (int i = 0; i < 8; ++i) sc += c8[i] * c8[i];
            const float rq = 1.0f / sqrtf(wave_sum(sq) * (1.0f / 1024.0f) + EPSN), rc = 1.0f / sqrtf(wave_sum(sc) * (1.0f / 512.0f) + EPSN), rk = 1.0f / sqrtf(wave_sum(kr * kr) * (1.0f / 64.0f) + EPSN);
            { v4u w;
              w.x = pk2(q[0] * rq * gq0.x, q[1] * rq * gq0.y); w.y = pk2(q[2] * rq * gq0.z, q[3] * rq * gq0.w); w.z = pk2(q[4] * rq * gq1.x, q[5] * rq * gq1.y); w.w = pk2(q[6] * rq * gq1.z, q[7] * rq * gq1.w);
              *(GAS v4u*)(QAN + (size_t)r * 1024 + 8 * lane) = w;
              w.x = pk2(q[8] * rq * gq2.x, q[9] * rq * gq2.y); w.y = pk2(q[10] * rq * gq2.z, q[11] * rq * gq2.w); w.z = pk2(q[12] * rq * gq3.x, q[13] * rq * gq3.y); w.w = pk2(q[14] * rq * gq3.z, q[15] * rq * gq3.w);
              *(GAS v4u*)(QAN + (size_t)r * 1024 + 512 + 8 * lane) = w; }
            const int cr = crow_of_row(r);
            float* ock = r < TP ? out + O_CKP + (size_t)r * 512 : out + O_CKS + (size_t)(r - TP) * 512;
            float* okr = r < TP ? out + O_KRP + (size_t)r * 64 : out + O_KRS + (size_t)(r - TP) * 64;
            { const f32x4 o0 = (f32x4){c8[0] * rc * gk0.x, c8[1] * rc * gk0.y, c8[2] * rc * gk0.z, c8[3] * rc * gk0.w}, o1 = (f32x4){c8[4] * rc * gk1.x, c8[5] * rc * gk1.y, c8[6] * rc * gk1.z, c8[7] * rc * gk1.w};
              *(GAS f32x4*)(ock + 8 * lane) = o0; *(GAS f32x4*)(ock + 8 * lane + 4) = o1;
              v4u w; w.x = pk2(o0.x, o0.y); w.y = pk2(o0.z, o0.w); w.z = pk2(o1.x, o1.y); w.w = pk2(o1.z, o1.w);
              *(GAS v4u*)(CALL + (size_t)cr * 512 + 8 * lane) = w; }
            { const float y = kr * rk * gkr; const float yp = __shfl_xor(y, 32);
              const float o = lane < 32 ? y * c - yp * sn : y * c + yp * sn;
              okr[lane] = o; KRA[(size_t)cr * 64 + lane] = (bf16)f2bf(o); }
        }
#undef P5_LOAD
    }
    SEAM(5);
    if (IN(6)) {
        const int c = (int)blockIdx.x; const bool part = (G == 256);
        if (!part || c < 120) { pg8::Gemm g{QAN, WUQ, TT, QLD, 1024}; pg8::StaticOrder S; S.init(TT, QLD, part ? 120 : G, c, 1024); pg8::EpiBf16P E{QH, QLD};
          pg8::gemm_phase<pg8::EpiBf16P, pg8::StaticOrder, true, true>(lds, g, S, E); }
        if (!part || (c >= 120 && c < 181)) { pg8::Gemm g{CALL, WUK, KROWS, KNLD, 512}; pg8::StaticOrder S; S.init(KROWS, KNLD, part ? 61 : G, part ? c - 120 : c, 512); pg8::EpiKNorm E{KN, KNLD, ARGIN(19), (LAS float*)(lds + RING_BYTES + 4096)};
          pg8::gemm_phase<pg8::EpiKNorm, pg8::StaticOrder, true, true>(lds, g, S, E); }
        if (!part || (c >= 181 && c < 242)) { pg8::Gemm g{WUV, CALL, 2048, KROWS, 512}; pg8::StaticOrder S; S.init(2048, KROWS, part ? 61 : G, part ? c - 181 : c, 512); pg8::EpiBf16P E{VT, KROWS};
          pg8::gemm_phase<pg8::EpiBf16P, pg8::StaticOrder, true, true>(lds, g, S, E); }
        if (part && c >= 242) { pg8::Gemm g{XN, WIN, TT, ZLD, DM}; pg8::WinOrder S; S.init(TT, ZLD, 256, c - 242, DM); S.r0 = 10; S.r1 = 11; pg8::EpiZ E{Z, ZLD, rcos, rsin};
          pg8::gemm_phase<pg8::EpiZ, pg8::WinOrder, true, true>(lds, g, S, E); }
    }
    SEAM(6);
    if (IN(8)) {
        constexpr int NQ_RP = 4, NQ_AP = 128, NQ_AS = 16, NQ_RS = 16, NQ = NQ_RP + NQ_AP + NQ_AS + NQ_RS;
        const int myx = (int)(xb_xcc_id() & 7u);
        if (G == 256 && (int)blockIdx.x >= 232) {
            LAS float* scr = (LAS float*)(lds + wave * 16384);
            BG_DRAIN(ctl + CW_BGQ + 128 + 64 * args.li, BGQ_B2, BGQ_B6);
            __syncthreads();
        }
        int qoff = 0;
        for (;;) {
            const int qx = (myx + qoff) & 7;
            if (tid == 0) MISC[0] = __hip_atomic_fetch_add(ctl + CW_QUEUE + 64 * (8 * args.li + qx), 1u, __ATOMIC_RELAXED, __HIP_MEMORY_SCOPE_AGENT);
            __syncthreads();
            const int li_ = (int)__builtin_amdgcn_readfirstlane(MISC[0]);
            __syncthreads();
            if (li_ >= NQ) { if (++qoff == 8) break; continue; }
            int kind, p0, p1, p2;
            bool is_ret;
            if (li_ < NQ_RP) { const int idx = qx * NQ_RP + li_; is_ret = true; kind = 0; p0 = idx >> 4; p1 = (idx >> 1) & 7; p2 = idx & 1; }
            else if (li_ < NQ_RP + NQ_AP + NQ_AS) {
                const int ua = li_ - NQ_RP;
                if (ua >= 112 && ua < 112 + NQ_AS) { const int u = qx * NQ_AS + (ua - 112); is_ret = false; kind = 1; p0 = 0; p1 = u >> 4; p2 = u & 15; }
                else { const int u = ua < 112 ? ua : ua - NQ_AS, bh = 4 * qx + (u & 3); is_ret = false; kind = 0; p0 = 31 - (u >> 2); p1 = bh >> 4; p2 = bh & 15; } }
            else { const int u = qx * NQ_RS + (li_ - NQ_RP - NQ_AP - NQ_AS); is_ret = true; kind = 1; p0 = u >> 4; p1 = (u >> 1) & 7; p2 = u & 1; }
            int tid2 = tid; asm volatile("" : "+v"(tid2));
            if (is_ret) {
#ifndef MK_NO_RET
                float* so = kind == 0 ? out + O_SRP + (size_t)(p0 * 8 + p1) * 65536 : out + O_SRS + (size_t)(p0 * 8 + p1) * 65536;
                ret_unit(lds, kind, p0, p1, p2, Z, XN, ARGIN(2), so, tid2);
#ifdef MK_RET2
                if (kind == 0) { asm volatile("" : "+v"(tid2)); ret_unit(lds, kind, p0, p1, p2, Z, XN, ARGIN(2), so, tid2); }
#endif
#endif
            } else {
#ifndef MK_NO_ATT
                const int qrow0 = kind == 0 ? p1 * SEQ + 256 * p0 : TP + 64 * p1, krow0 = kind == 0 ? p1 * SEQ : TP + 1088 * p1;
                attn_unit(lds, qrow0, kind == 0 ? 8 : 2, krow0, kind == 0 ? 4 * p0 + 4 : 17, kind == 0 ? 4 * p0 : -1, p2, QH, KN, KRA, VT, XN, tid2, ARGIN(14), ARGIN(15), mcos, msin);
#endif
            }
        }
    }
    SEAM(8);
    if (IN(9)) {
#define P9_DPP(x, ctrl) __builtin_bit_cast(float, __builtin_amdgcn_update_dpp(0, __builtin_bit_cast(int, (float)(x)), (ctrl), 0xF, 0xF, false))
#define P9_SUM32(v) do { v += P9_DPP(v, 0xB1); v += P9_DPP(v, 0x4E); v += P9_DPP(v, 0x141); v += P9_DPP(v, 0x140); v += __shfl_xor(v, 16); } while (0)
        v4u pn[4], pg[4];
        f32x4 gg[8];
        { const float* gp = ARGIN(11);
#pragma unroll
          for (int k = 0; k < 4; ++k) { gg[2 * k] = *(const GAS f32x4*)(gp + 512 * k + 8 * lane); gg[2 * k + 1] = *(const GAS f32x4*)(gp + 512 * k + 8 * lane + 4); } }
#define P9_LOAD(rr) do { const bf16* b_ = XN + (size_t)(rr) * DM + 8 * lane; const bf16* g_ = Z + (size_t)(rr) * ZLD + 6144 + 8 * lane; \
            _Pragma("unroll") for (int k = 0; k < 4; ++k) { pn[k] = *(const GAS v4u*)(b_ + 512 * k); pg[k] = *(const GAS v4u*)(g_ + 512 * k); } } while (0)
        if (gw < TT) P9_LOAD(gw);
        for (int r = gw; r < TT; r += NGW) {
            bf16* base = XN + (size_t)r * DM + 8 * lane;
            v4u nv[4], gv[4];
#pragma unroll
            for (int k = 0; k < 4; ++k) { nv[k] = pn[k]; gv[k] = pg[k]; }
            if (r + NGW < TT) P9_LOAD(r + NGW);
#pragma unroll
            for (int k = 0; k < 4; ++k) { float x[8], gt[8];
                x[0] = bflo(nv[k].x); x[1] = bfhi(nv[k].x); x[2] = bflo(nv[k].y); x[3] = bfhi(nv[k].y); x[4] = bflo(nv[k].z); x[5] = bfhi(nv[k].z); x[6] = bflo(nv[k].w); x[7] = bfhi(nv[k].w);
                gt[0] = bflo(gv[k].x); gt[1] = bfhi(gv[k].x); gt[2] = bflo(gv[k].y); gt[3] = bfhi(gv[k].y); gt[4] = bflo(gv[k].z); gt[5] = bfhi(gv[k].z); gt[6] = bflo(gv[k].w); gt[7] = bfhi(gv[k].w);
                float sm = ((x[0] + x[1]) + (x[2] + x[3])) + ((x[4] + x[5]) + (x[6] + x[7]));
                P9_SUM32(sm);
                const float mu = sm * (1.0f / 256.0f); float sv = 0.f;
#pragma unroll
                for (int i = 0; i < 8; ++i) { x[i] -= mu; sv += x[i] * x[i]; }
                P9_SUM32(sv);
                const float rs = 1.0f / sqrtf(sv * (1.0f / 256.0f) + EPSN);
                float o[8];
#pragma unroll
                for (int i = 0; i < 8; ++i) o[i] = x[i] * rs * gg[2 * k + (i >> 2)][i & 3] * pg8::fast_silu(gt[i]);
                v4u w; w.x = pk2(o[0], o[1]); w.y = pk2(o[2], o[3]); w.z = pk2(o[4], o[5]); w.w = pk2(o[6], o[7]); *(GAS v4u*)(base + 512 * k) = w; }
        }
#undef P9_LOAD
#undef P9_SUM32
#undef P9_DPP
    }
    SEAM(9);
    if (IN(10)) { pg8::Gemm g{XN, WOUT, TT, DM, DM}; pg8::SplitTailOrder S; S.init(TT, DM, G, (int)blockIdx.x, DM); pg8::EpiResid<true> E{nullptr, nullptr, 1 << 20, HB, DM, 1.0f, DM / 64, slabs};
        pg8::gemm_phase<pg8::EpiResid<true>, pg8::SplitTailOrder, true, true>(lds, g, S, E); }
    SEAM(10);
    if (IN(11)) { LAS unsigned char* tab = lds; build_split_tab(tab, G, DM, tid, 8);
        norm_phase_h<true>(HB, ARGIN(21), XN, nullptr, gw, NGW, lane, tab, slabs, 1.0f, 8); }
    SEAM(11);
    if (IN(12)) { pg8::Gemm g{XN, W2GU, TT, 2 * DFF, DM}; pg8::StaticOrder S; S.init(TT, 2 * DFF, G, (int)blockIdx.x, DM); pg8::EpiSwiGLU E{HID, DFF};
        pg8::gemm_phase<pg8::EpiSwiGLU, pg8::StaticOrder, true, true>(lds, g, S, E); }
    SEAM(12);
    if (IN(13)) { pg8::Gemm g{HID, W2D, TT, DM, DFF}; pg8::SplitTailOrder S; S.init(TT, DM, G, (int)blockIdx.x, DFF); S.wgm = MK_WGM_DOWN; pg8::EpiResid<true> E{nullptr, nullptr, 1 << 20, HB, DM, 0.5f, DFF / 64, slabs};
        pg8::gemm_phase<pg8::EpiResid<true>, pg8::SplitTailOrder, true, true>(lds, g, S, E); }
    SEAM(13);
    if (IN(14)) { LAS unsigned char* tab = lds; build_split_tab(tab, G, DFF, tid, MK_WGM_DOWN);
        norm_phase_y(HB, ARGIN(25), out, gw, NGW, lane, tab, slabs, 0.5f, 8); }
#ifdef MK_PROBE_SUMS
    if (lo <= 14 && 14 < hi) {
        const int gt = blockIdx.x * (NWAVES * 64) + tid, NGT = G * NWAVES * 64;
        for (size_t i = gt; i < (size_t)TT * DM; i += NGT) if (i >= 65536) out[i] = 0.f;
        for (int r = gw; r < TT + KROWS + 2048; r += NGW) {
            const bf16* src; int n;
            if (r < TT) { src = QH + (size_t)r * QLD; n = QLD; } else if (r < TT + KROWS) { src = KN + (size_t)(r - TT) * KNLD; n = KNLD; } else { src = VT + (size_t)(r - TT - KROWS) * KROWS; n = KROWS; }
            float s = 0.f;
            for (int i = lane; i < n; i += 64) s += bflo((unsigned)src[i]) * (float)(1 + (i & 7));
            s = wave_sum(s);
            if (lane == 0) out[r] = s;
        }
    }
#endif
#ifdef MK_NO_RET
    if (lo <= 14 && 14 < hi) {
#else
    if (!((MK_PHASE_MASK >> 8) & 1) && lo <= 14 && 14 < hi) {
#endif
        const int gt = blockIdx.x * (NWAVES * 64) + tid, NGT = G * NWAVES * 64;
        for (int i = gt; i < 1048576; i += NGT) out[O_SRP + i] = 0.f;
        for (int i = gt; i < 4194304; i += NGT) out[O_SRS + i] = 0.f;
    }
#undef IN
#undef SEAM
}

#ifndef MK_CUT
#define MK_CUT 0
#endif
extern "C" void kernel_launch(void* const* d_in, const int* in_sizes, int n_in, void* d_out, int out_size, void* d_ws, size_t ws_size, hipStream_t stream) {
    static int grid = 0;
    if (grid == 0) {
        if (n_in != 26 || (size_t)out_size != O_END || ws_size < WS_END) { fprintf(stderr, "kernel_launch: unexpected problem (n_in %d, out %d, ws %zu < %zu); nothing launched\n", n_in, out_size, ws_size, (size_t)WS_END); grid = -1; return; }
        int dev = 0, cus = 0, per_cu = 0;
        if (hipGetDevice(&dev) != hipSuccess || hipDeviceGetAttribute(&cus, hipDeviceAttributeMultiprocessorCount, dev) != hipSuccess) { grid = -1; return; }
        if (hipFuncSetAttribute((const void*)mk_fwd, hipFuncAttributeMaxDynamicSharedMemorySize, LDS_BYTES) != hipSuccess) { fprintf(stderr, "kernel_launch: hipFuncSetAttribute failed\n"); grid = -1; return; }
        if (hipOccupancyMaxActiveBlocksPerMultiprocessor(&per_cu, (const void*)mk_fwd, NWAVES * 64, LDS_BYTES) != hipSuccess || per_cu < 1) { fprintf(stderr, "kernel_launch: occupancy query says %d blocks per CU\n", per_cu); }
        (void)hipGetLastError();
        grid = cus;
    }
    if (grid < 0) return;
    (void)hipMemsetAsync((char*)d_ws + WS_CTL, 0, CTL_ZERO_BYTES, stream);
    Args a{};
    for (int i = 0; i < 26; ++i) a.in[i] = (const float*)d_in[i];
    a.out = (float*)d_out; a.ws = (unsigned char*)d_ws; a.li = 0; a.pad1 = 0;
#if MK_CUT
    for (int p = 0; p < N_PHASES; ++p) { a.ph_lo = p; a.ph_hi = p + 1; hipLaunchKernelGGL(mk_fwd, dim3(grid), dim3(NWAVES * 64), LDS_BYTES, stream, a); }
#elif defined(MK_DUP_LO)
    a.ph_lo = 0; a.ph_hi = MK_DUP_HI; a.li = 0;
    hipLaunchKernelGGL(mk_fwd, dim3(grid), dim3(NWAVES * 64), LDS_BYTES, stream, a);
    a.ph_lo = MK_DUP_LO; a.ph_hi = N_PHASES; a.li = 1;
    hipLaunchKernelGGL(mk_fwd, dim3(grid), dim3(NWAVES * 64), LDS_BYTES, stream, a);
#else
    a.ph_lo = 0; a.ph_hi = N_PHASES;
    hipLaunchKernelGGL(mk_fwd, dim3(grid), dim3(NWAVES * 64), LDS_BYTES, stream, a);
#endif
}
```

```cpp
#include <hip/hip_runtime.h>
#include <cstdio>
#include <cstdint>
namespace pg8 {
#define PG8_LAS __attribute__((address_space(3)))
typedef unsigned short bf16_t;
typedef short bf16x8 __attribute__((ext_vector_type(8)));
typedef float f32x4 __attribute__((ext_vector_type(4)));
typedef unsigned u32x4 __attribute__((ext_vector_type(4)));
constexpr int BM = 256, BK = 64, HALF = 128, HTB = HALF * BK * 2  , STAGE_BYTES = 8 * HTB, NXCD = 8, WGM = 8;

__host__ __device__ __forceinline__ int lds_byte(int r, int c) { const int st = (r >> 4) * 2 + (c >> 5), rr = r & 15, cc = c & 31, ob = rr * 64 + cc * 2; return st * 1024 + (ob ^ (((ob >> 9) & 1) << 5)); }
__host__ __device__ __forceinline__ void stage_rc(int b, int& R, int& C) { const int st = b / 1024, sb = b % 1024, swz = sb ^ (((sb >> 9) & 1) << 5); R = (st >> 1) * 16 + swz / 64; C = (st & 1) * 32 + (swz % 64) / 2; }
__host__ __device__ __forceinline__ int perm32(int rho) { const int n = rho >> 4, i = rho & 15; return 8 * (i >> 2) + 4 * n + (i & 3); }

struct Unit { int pm, pn, kt0, nt; };
struct Gemm { const bf16_t* A; const bf16_t* Bt; int M, N, K; };

struct StaticOrder {
    int nM, nN, nwg, G, c, ntk, wgm;
    __host__ __device__ __forceinline__ void init(int M, int N, int G_, int c_, int K) { nM = M / BM; nN = N / BM; nwg = nM * nN; G = G_; c = c_; ntk = K / BK; wgm = WGM; }
    __host__ __device__ __forceinline__ void tile(int L, Unit& u) const {
        int wgid = L; { const int q = nwg / NXCD, r = nwg % NXCD, xcd = wgid % NXCD, off = wgid / NXCD; wgid = (xcd < r ? xcd * (q + 1) : r * (q + 1) + (xcd - r) * q) + off; }
        const int nig = wgm * nN, gid = wgid / nig, fm = gid * wgm, gsz = (nM - fm) < wgm ? (nM - fm) : wgm;
        u.pm = fm + ((wgid % nig) % gsz); u.pn = (wgid % nig) / gsz;
    }
    __host__ __device__ __forceinline__ bool next(int i, Unit& u) const {
        const long L = (long)i * G + c; if (L >= nwg) return false;
        tile((int)L, u); u.kt0 = 0; u.nt = ntk; return true;
    }
    __device__ __forceinline__ void a_ready(const Unit&) const {}
    __device__ __forceinline__ void done(const Unit&) const {}
};
struct SplitTailOrder : StaticOrder {
    __host__ __device__ __forceinline__ bool next(int i, Unit& u) const {
        const int R = nwg / G, rem = nwg - R * G;
        if (i < R) { tile(i * G + c, u); u.kt0 = 0; u.nt = ntk; return true; }
        if (i > R || rem == 0) return false;
        const int S = G / rem, t = c / S, p = c - t * S; if (t >= rem) return false;
        tile(R * G + t, u);
        const int pairs = ntk / 2, q = pairs / S, r = pairs - q * S;
        u.kt0 = 2 * (p * q + (p < r ? p : r)); u.nt = 2 * (q + (p < r ? 1 : 0)); return true;
    }
};
struct WinOrder : StaticOrder {
    int r0, r1;
    __host__ __device__ __forceinline__ bool next(int i, Unit& u) const {
        const int r = i + r0; const long L = (long)r * G + c; if (r >= r1 || L >= nwg) return false;
        tile((int)L, u); u.pn += 10; if (u.pn >= nN) u.pn -= nN; u.kt0 = 0; u.nt = ntk; return true;
    }
};
typedef float f32x2_t __attribute__((ext_vector_type(2))); typedef __bf16 bf16x2_t __attribute__((ext_vector_type(2)));
__device__ __forceinline__ unsigned cvt_pk_bf16(float lo, float hi) { f32x2_t v = {lo, hi}; bf16x2_t b = __builtin_convertvector(v, bf16x2_t); return __builtin_bit_cast(unsigned, b); }
typedef float f32x2 __attribute__((ext_vector_type(2)));
__device__ __forceinline__ float fast_silu(float g) { return g * __builtin_amdgcn_rcpf(1.0f + __builtin_amdgcn_exp2f(-1.4426950408889634f * g)); }
struct EpiSwiGLU {
    static constexpr bool PERM = true, AFTER_DRAIN = false;
    bf16_t* H; int ldh;
    __device__ __forceinline__ void operator()(const f32x4 (&acc)[2][2][4][2], const Unit& u, int wr, int wc, int fr, int fq) const {
        const int row0 = u.pm * BM + wr * 64 + fr, col0 = u.pn * HALF + wc * 32 + 8 * fq;
#pragma unroll
        for (int ai = 0; ai < 2; ++ai)
#pragma unroll
            for (int m = 0; m < 4; ++m) { bf16_t* rowp = H + (size_t)(row0 + ai * HALF + m * 16) * ldh + col0;
                const f32x4 g0 = acc[ai][0][m][0], g1 = acc[ai][0][m][1], u0 = acc[ai][1][m][0], u1 = acc[ai][1][m][1];
                f32x4 v0, v1;
#pragma unroll
                for (int j = 0; j < 4; ++j) { v0[j] = fast_silu(g0[j]) * u0[j]; v1[j] = fast_silu(g1[j]) * u1[j]; }
                u32x4 w; w.x = cvt_pk_bf16(v0[0], v0[1]); w.y = cvt_pk_bf16(v0[2], v0[3]); w.z = cvt_pk_bf16(v1[0], v1[1]); w.w = cvt_pk_bf16(v1[2], v1[3]);
                *(u32x4*)rowp = w; }
    }
};
template <bool BASE_BF16> struct EpiResid {
    static constexpr bool PERM = true, AFTER_DRAIN = false;
    const float* base0; const float* base1; int split_pm; bf16_t* hout; int ldc; float alpha; int ntk_full; float* slabs;
    __device__ __forceinline__ void operator()(const f32x4 (&acc)[2][2][4][2], const Unit& u, int wr, int wc, int fr, int fq) const {
        const int row0 = u.pm * BM + wr * 64 + fr, col0 = u.pn * BM + wc * 32 + 8 * fq;
        if (u.nt != ntk_full) {
            bf16_t* sp = (bf16_t*)slabs + (size_t)blockIdx.x * 65536 + (size_t)(wr * 64 + fr) * 256 + wc * 32 + 8 * fq;
#pragma unroll
            for (int ai = 0; ai < 2; ++ai)
#pragma unroll
                for (int m = 0; m < 4; ++m) {
#pragma unroll
                    for (int bj = 0; bj < 2; ++bj) { const f32x4 a0 = acc[ai][bj][m][0], a1 = acc[ai][bj][m][1];
                        u32x4 w; w.x = cvt_pk_bf16(a0[0], a0[1]); w.y = cvt_pk_bf16(a0[2], a0[3]); w.z = cvt_pk_bf16(a1[0], a1[1]); w.w = cvt_pk_bf16(a1[2], a1[3]); *(u32x4*)(sp + bj * HALF) = w; }
                    sp += (m == 3 ? (HALF - 48) : 16) * 256; asm volatile("" : "+v"(sp)); }
            return;
        }
        const float* bb = (u.pm >= split_pm) ? base1 - (size_t)split_pm * BM * ldc : base0;
        if constexpr (BASE_BF16) {
            u32x4 bw[2][4][2];
#pragma unroll
            for (int ai = 0; ai < 2; ++ai)
#pragma unroll
                for (int m = 0; m < 4; ++m) { const size_t off = (size_t)(row0 + ai * HALF + m * 16) * ldc + col0;
#pragma unroll
                    for (int bj = 0; bj < 2; ++bj) bw[ai][m][bj] = *(const u32x4*)(hout + off + bj * HALF); }
#pragma unroll
            for (int ai = 0; ai < 2; ++ai)
#pragma unroll
                for (int m = 0; m < 4; ++m) { const size_t off = (size_t)(row0 + ai * HALF + m * 16) * ldc + col0;
#pragma unroll
                    for (int bj = 0; bj < 2; ++bj) { const u32x4 b4 = bw[ai][m][bj];
                        const f32x4 b0 = (f32x4){__builtin_bit_cast(float, b4.x << 16), __builtin_bit_cast(float, b4.x & 0xffff0000u), __builtin_bit_cast(float, b4.y << 16), __builtin_bit_cast(float, b4.y & 0xffff0000u)};
                        const f32x4 b1 = (f32x4){__builtin_bit_cast(float, b4.z << 16), __builtin_bit_cast(float, b4.z & 0xffff0000u), __builtin_bit_cast(float, b4.w << 16), __builtin_bit_cast(float, b4.w & 0xffff0000u)};
                        const f32x4 h0 = b0 + alpha * acc[ai][bj][m][0], h1 = b1 + alpha * acc[ai][bj][m][1];
                        u32x4 w; w.x = cvt_pk_bf16(h0[0], h0[1]); w.y = cvt_pk_bf16(h0[2], h0[3]); w.z = cvt_pk_bf16(h1[0], h1[1]); w.w = cvt_pk_bf16(h1[2], h1[3]); *(u32x4*)(hout + off + bj * HALF) = w; } }
        } else {
#pragma unroll
            for (int ai = 0; ai < 2; ++ai) {
                f32x4 bv[4][2][2];
#pragma unroll
                for (int m = 0; m < 4; ++m) { const size_t off = (size_t)(row0 + ai * HALF + m * 16) * ldc + col0;
#pragma unroll
                    for (int bj = 0; bj < 2; ++bj)
#pragma unroll
                        for (int n = 0; n < 2; ++n) bv[m][bj][n] = __builtin_nontemporal_load((const f32x4*)(bb + off + bj * HALF + n * 4)); }
#pragma unroll
                for (int m = 0; m < 4; ++m) { const size_t off = (size_t)(row0 + ai * HALF + m * 16) * ldc + col0;
#pragma unroll
                    for (int bj = 0; bj < 2; ++bj) { const f32x4 h0 = bv[m][bj][0] + alpha * acc[ai][bj][m][0], h1 = bv[m][bj][1] + alpha * acc[ai][bj][m][1];
                        u32x4 w; w.x = cvt_pk_bf16(h0[0], h0[1]); w.y = cvt_pk_bf16(h0[2], h0[3]); w.z = cvt_pk_bf16(h1[0], h1[1]); w.w = cvt_pk_bf16(h1[2], h1[3]); *(u32x4*)(hout + off + bj * HALF) = w; } }
                asm volatile("" ::: "memory"); }
        }
    }
};
struct EpiZ {
    static constexpr bool PERM = true, AFTER_DRAIN = false;
    bf16_t* Z; int ldz; const float* rcos; const float* rsin;
    __device__ __forceinline__ void operator()(const f32x4 (&acc)[2][2][4][2], const Unit& u, int wr, int wc, int fr, int fq) const {
        const int row0 = u.pm * BM + wr * 64 + fr, col0 = u.pn * BM + wc * 32 + 8 * fq;
        const bool rope = u.pn < 16; const float sc = (u.pn >= 8 && u.pn < 16) ? 0.0625f : 1.0f;
#pragma unroll
        for (int ai = 0; ai < 2; ++ai)
#pragma unroll
            for (int m = 0; m < 4; ++m) { const int r = row0 + ai * HALF + m * 16; bf16_t* rowp = Z + (size_t)r * ldz + col0;
                f32x4 a0 = acc[ai][0][m][0], a1 = acc[ai][0][m][1], b0 = acc[ai][1][m][0], b1 = acc[ai][1][m][1];
                if (rope) { const int pos = r < 16384 ? (r & 8191) : 1024 + ((r - 16384) & 63);
                    const float* cp = rcos + (size_t)pos * 128 + wc * 32 + 8 * fq; const float* sp = rsin + (size_t)pos * 128 + wc * 32 + 8 * fq;
                    const f32x4 c0 = *(const f32x4*)cp, c1 = *(const f32x4*)(cp + 4), s0 = *(const f32x4*)sp, s1 = *(const f32x4*)(sp + 4);
                    const f32x4 x0 = a0, x1 = a1, y0 = b0, y1 = b1;
                    a0 = (x0 * c0 - y0 * s0) * sc; a1 = (x1 * c1 - y1 * s1) * sc; b0 = (y0 * c0 + x0 * s0) * sc; b1 = (y1 * c1 + x1 * s1) * sc; }
                u32x4 w; w.x = cvt_pk_bf16(a0[0], a0[1]); w.y = cvt_pk_bf16(a0[2], a0[3]); w.z = cvt_pk_bf16(a1[0], a1[1]); w.w = cvt_pk_bf16(a1[2], a1[3]);
                *(u32x4*)rowp = w;
                w.x = cvt_pk_bf16(b0[0], b0[1]); w.y = cvt_pk_bf16(b0[2], b0[3]); w.z = cvt_pk_bf16(b1[0], b1[1]); w.w = cvt_pk_bf16(b1[2], b1[3]);
                *(u32x4*)(rowp + HALF) = w; }
    }
};
struct EpiBf16P {
    static constexpr bool PERM = true, AFTER_DRAIN = false;
    bf16_t* O; int ldc;
    __device__ __forceinline__ void operator()(const f32x4 (&acc)[2][2][4][2], const Unit& u, int wr, int wc, int fr, int fq) const {
        const int row0 = u.pm * BM + wr * 64 + fr, col0 = u.pn * BM + wc * 32 + 8 * fq;
#pragma unroll
        for (int ai = 0; ai < 2; ++ai)
#pragma unroll
            for (int m = 0; m < 4; ++m) { bf16_t* rowp = O + (size_t)(row0 + ai * HALF + m * 16) * ldc + col0;
#pragma unroll
                for (int bj = 0; bj < 2; ++bj) { const f32x4 v0 = acc[ai][bj][m][0], v1 = acc[ai][bj][m][1];
                    u32x4 w; w.x = cvt_pk_bf16(v0[0], v0[1]); w.y = cvt_pk_bf16(v0[2], v0[3]); w.z = cvt_pk_bf16(v1[0], v1[1]); w.w = cvt_pk_bf16(v1[2], v1[3]);
                    *(u32x4*)(rowp + bj * HALF) = w; } }
    }
};
struct EpiKNorm {
    static constexpr bool PERM = true, AFTER_DRAIN = false;
    bf16_t* O; int ldc; const float* gk; PG8_LAS float* tab;
    __device__ __forceinline__ void operator()(const f32x4 (&acc)[2][2][4][2], const Unit& u, int wr, int wc, int fr, int fq) const {
        const int row0 = u.pm * BM + wr * 64 + fr, col0 = u.pn * BM + wc * 32 + 8 * fq;
#pragma unroll
        for (int ai = 0; ai < 2; ++ai)
#pragma unroll
            for (int m = 0; m < 4; ++m)
#pragma unroll
                for (int bj = 0; bj < 2; ++bj) { const f32x4 v0 = acc[ai][bj][m][0], v1 = acc[ai][bj][m][1];
                    float ss = (v0[0] * v0[0] + v0[1] * v0[1]) + (v0[2] * v0[2] + v0[3] * v0[3]) + (v1[0] * v1[0] + v1[1] * v1[1]) + (v1[2] * v1[2] + v1[3] * v1[3]);
                    ss += __shfl_xor(ss, 16); ss += __shfl_xor(ss, 32);
                    if (fq == 0) tab[((ai * HALF + wr * 64 + m * 16 + fr) * 2 + bj) * 4 + wc] = ss; }
        asm volatile("s_waitcnt lgkmcnt(0)" ::: "memory"); __builtin_amdgcn_s_barrier(); asm volatile("" ::: "memory");
        const f32x4 g0 = *(const f32x4*)(gk + wc * 32 + 8 * fq), g1 = *(const f32x4*)(gk + wc * 32 + 8 * fq + 4);
#pragma unroll
        for (int ai = 0; ai < 2; ++ai)
#pragma unroll
            for (int m = 0; m < 4; ++m) { bf16_t* rowp = O + (size_t)(row0 + ai * HALF + m * 16) * ldc + col0;
#pragma unroll
                for (int bj = 0; bj < 2; ++bj) { const f32x4 pr = *(const PG8_LAS f32x4*)(tab + ((ai * HALF + wr * 64 + m * 16 + fr) * 2 + bj) * 4);
                    const float rs = __builtin_amdgcn_rsqf(((pr[0] + pr[1]) + (pr[2] + pr[3])) * (1.0f / 128.0f) + 1e-6f);
                    const f32x4 v0 = acc[ai][bj][m][0] * rs * g0, v1 = acc[ai][bj][m][1] * rs * g1;
                    u32x4 w; w.x = cvt_pk_bf16(v0[0], v0[1]); w.y = cvt_pk_bf16(v0[2], v0[3]); w.z = cvt_pk_bf16(v1[0], v1[1]); w.w = cvt_pk_bf16(v1[2], v1[3]);
                    *(u32x4*)(rowp + bj * HALF) = w; } }
    }
};
template <class Epi, class Sched, bool ALIGN_EPI = false, bool SP2 = false>
__device__ __forceinline__ void gemm_phase(PG8_LAS unsigned char* lds, const Gemm g, const Sched& S, const Epi& E) {
    const int tid = threadIdx.x, wid = __builtin_amdgcn_readfirstlane(tid >> 6), lane = tid & 63, wr = wid >> 2, wc = wid & 3, fr = lane & 15, fq = lane >> 4;
    const int K = g.K;
    unsigned voffA[2], voffB[2];
#pragma unroll
    for (int i = 0; i < 2; ++i) { int R, C; stage_rc(tid * 16 + i * 8192, R, C); const int Rb = Epi::PERM ? ((R & ~31) + perm32(R & 31)) : R;
        voffA[i] = (unsigned)(R * K + C) * 2u; voffB[i] = (unsigned)(Rb * K + C) * 2u; }
    const size_t kstep = (size_t)(BK * 2);
    const size_t hstep = (size_t)HALF * K * 2;
    const size_t tstep = 2 * hstep;
    const unsigned ldsw = (unsigned)wid * 1024u;
    const int aoff = lds_byte(wr * 64 + fr, fq * 8), boff = lds_byte(wc * 32 + fr, fq * 8);
#define PG8_SA(b, h) (((b) * 2 + (h)) * HTB)
#define PG8_SB(b, h) ((4 + (b) * 2 + (h)) * HTB)
#define PG8_STAGE(bufoff, gbase, voff) do { _Pragma("unroll") for (int _i = 0; _i < 2; ++_i) \
        __builtin_amdgcn_global_load_lds((const unsigned*)((const char*)(gbase) + (voff)[_i]), (PG8_LAS unsigned*)(lds + (bufoff) + ldsw + _i * 8192), 16, 0, 0); } while (0)
#define PG8_LDA(dst, b, h) do { _Pragma("unroll") for (int m = 0; m < 4; ++m) _Pragma("unroll") for (int k = 0; k < 2; ++k) dst[m][k] = *(const PG8_LAS bf16x8*)(lds + PG8_SA(b, h) + aoff + m * 2048 + k * 1024); } while (0)
#define PG8_LDB(dst, b, h) do { _Pragma("unroll") for (int n = 0; n < 2; ++n) _Pragma("unroll") for (int k = 0; k < 2; ++k) dst[n][k] = *(const PG8_LAS bf16x8*)(lds + PG8_SB(b, h) + boff + n * 2048 + k * 1024); } while (0)
#define PG8_MMA(ai, bj, At, Bt) do { __builtin_amdgcn_s_setprio(1); _Pragma("unroll") for (int m = 0; m < 4; ++m) _Pragma("unroll") for (int n = 0; n < 2; ++n) _Pragma("unroll") for (int k = 0; k < 2; ++k) \
        acc[ai][bj][m][n] = __builtin_amdgcn_mfma_f32_16x16x32_bf16(Bt[n][k], At[m][k], acc[ai][bj][m][n], 0, 0, 0); __builtin_amdgcn_s_setprio(0); } while (0)
#define PG8_WAIT_V(n) asm volatile("s_waitcnt vmcnt(" #n ")" ::: "memory")
#define PG8_WAIT_L(n) asm volatile("s_waitcnt lgkmcnt(" #n ")" ::: "memory")
#define PG8_BAR __builtin_amdgcn_s_barrier()
#define PG8_SCHED __builtin_amdgcn_sched_barrier(0)
    Unit cur, nxt; int ui = 0;
    if (!S.next(0, cur)) return;
    f32x4 acc[2][2][4][2];
#pragma unroll
    for (int a = 0; a < 2; ++a)
#pragma unroll
        for (int b = 0; b < 2; ++b)
#pragma unroll
            for (int m = 0; m < 4; ++m)
#pragma unroll
                for (int n = 0; n < 2; ++n) acc[a][b][m][n] = (f32x4){0.f, 0.f, 0.f, 0.f};
    bf16x8 At[4][2], B0[2][2], B1[2][2];
    const char* cA = (const char*)g.A + (size_t)cur.pm * tstep + (size_t)cur.kt0 * kstep; const char* cB = (const char*)g.Bt + (size_t)cur.pn * tstep + (size_t)cur.kt0 * kstep;
    S.a_ready(cur);
    if constexpr (SP2) {
        PG8_STAGE(PG8_SB(0, 0), cB, voffB); PG8_STAGE(PG8_SB(0, 1), cB + hstep, voffB); PG8_STAGE(PG8_SA(0, 0), cA, voffA); PG8_STAGE(PG8_SA(0, 1), cA + hstep, voffA);
        if (wr == 1) PG8_BAR;
        PG8_WAIT_V(2); PG8_BAR;
        PG8_STAGE(PG8_SB(1, 0), cB + kstep, voffB); PG8_STAGE(PG8_SA(1, 0), cA + kstep, voffA); PG8_STAGE(PG8_SB(1, 1), cB + hstep + kstep, voffB);
        PG8_WAIT_V(6); PG8_BAR;
    } else {
        PG8_STAGE(PG8_SB(0, 0), cB, voffB); PG8_STAGE(PG8_SA(0, 0), cA, voffA); PG8_STAGE(PG8_SB(0, 1), cB + hstep, voffB); PG8_STAGE(PG8_SA(0, 1), cA + hstep, voffA);
        if (wr == 1) PG8_BAR;
        PG8_WAIT_V(4); PG8_BAR;
        PG8_STAGE(PG8_SB(1, 0), cB + kstep, voffB); PG8_STAGE(PG8_SA(1, 0), cA + kstep, voffA); PG8_STAGE(PG8_SB(1, 1), cB + hstep + kstep, voffB);
        PG8_WAIT_V(6); PG8_BAR;
    }
    for (;;) {
        const bool has_next = S.next(ui + 1, nxt);
        const char* nA = has_next ? (const char*)g.A + (size_t)nxt.pm * tstep + (size_t)nxt.kt0 * kstep : cA; const char* nB = has_next ? (const char*)g.Bt + (size_t)nxt.pn * tstep + (size_t)nxt.kt0 * kstep : cB;
        const int nt = cur.nt;
        for (int t = 0; t < nt; t += 2) {
            const bool last = (t == nt - 2);
            const char* a1 = cA + (size_t)(t + 1) * kstep;
            const char* a2 = last ? nA : cA + (size_t)(t + 2) * kstep; const char* b2 = last ? nB : cB + (size_t)(t + 2) * kstep;
            const char* a3 = a2 + kstep; const char* b3 = b2 + kstep;
            if (last && has_next) S.a_ready(nxt);
            if constexpr (SP2) {
            PG8_LDB(B0, 0, 0); PG8_LDB(B1, 0, 1); PG8_SCHED; PG8_LDA(At, 0, 0); PG8_STAGE(PG8_SA(1, 1), a1 + hstep, voffA);
            PG8_WAIT_V(8); PG8_WAIT_L(0); PG8_BAR; PG8_MMA(0, 0, At, B0); PG8_MMA(0, 1, At, B1); PG8_BAR; PG8_SCHED;
            PG8_LDA(At, 0, 1); PG8_STAGE(PG8_SB(0, 0), b2, voffB); PG8_STAGE(PG8_SB(0, 1), b2 + hstep, voffB); PG8_STAGE(PG8_SA(0, 0), a2, voffA);
            PG8_WAIT_V(8); PG8_WAIT_L(0); PG8_BAR; PG8_MMA(1, 0, At, B0); PG8_MMA(1, 1, At, B1); PG8_BAR; PG8_SCHED;
            PG8_LDB(B0, 1, 0); PG8_LDB(B1, 1, 1); PG8_SCHED; PG8_LDA(At, 1, 0); PG8_STAGE(PG8_SA(0, 1), a2 + hstep, voffA);
            PG8_WAIT_V(8); PG8_WAIT_L(0); PG8_BAR; PG8_MMA(0, 0, At, B0); PG8_MMA(0, 1, At, B1); PG8_BAR; PG8_SCHED;
            PG8_LDA(At, 1, 1); PG8_STAGE(PG8_SB(1, 0), b3, voffB); PG8_STAGE(PG8_SB(1, 1), b3 + hstep, voffB); PG8_STAGE(PG8_SA(1, 0), a3, voffA);
            PG8_WAIT_V(8); PG8_WAIT_L(0); PG8_BAR; PG8_MMA(1, 0, At, B0); PG8_MMA(1, 1, At, B1); PG8_BAR; PG8_SCHED;
            } else {
            PG8_LDB(B0, 0, 0); PG8_SCHED; PG8_LDA(At, 0, 0); PG8_STAGE(PG8_SA(1, 1), a1 + hstep, voffA);
            PG8_WAIT_L(8); PG8_BAR; PG8_WAIT_L(0); PG8_MMA(0, 0, At, B0); PG8_BAR; PG8_SCHED;
            PG8_LDB(B1, 0, 1); PG8_STAGE(PG8_SB(0, 0), b2, voffB);
            PG8_BAR; PG8_WAIT_L(0); PG8_MMA(0, 1, At, B1); PG8_BAR;
            PG8_LDA(At, 0, 1); PG8_STAGE(PG8_SA(0, 0), a2, voffA);
            PG8_BAR; PG8_WAIT_L(0); PG8_MMA(1, 0, At, B0); PG8_BAR; PG8_SCHED;
            PG8_STAGE(PG8_SB(0, 1), b2 + hstep, voffB);
            PG8_WAIT_V(6); PG8_BAR; PG8_MMA(1, 1, At, B1); PG8_BAR;
            PG8_LDB(B0, 1, 0); PG8_SCHED; PG8_LDA(At, 1, 0); PG8_STAGE(PG8_SA(0, 1), a2 + hstep, voffA);
            PG8_WAIT_L(8); PG8_BAR; PG8_WAIT_L(0); PG8_MMA(0, 0, At, B0); PG8_BAR; PG8_SCHED;
            PG8_LDB(B1, 1, 1); PG8_STAGE(PG8_SB(1, 0), b3, voffB);
            PG8_BAR; PG8_WAIT_L(0); PG8_MMA(0, 1, At, B1); PG8_BAR;
            PG8_LDA(At, 1, 1); PG8_STAGE(PG8_SA(1, 0), a3, voffA);
            PG8_BAR; PG8_WAIT_L(0); PG8_MMA(1, 0, At, B0); PG8_BAR; PG8_SCHED;
            PG8_STAGE(PG8_SB(1, 1), b3 + hstep, voffB);
            PG8_WAIT_V(6); PG8_BAR; PG8_MMA(1, 1, At, B1); PG8_BAR;
            }
        }
        if constexpr (ALIGN_EPI) { if (wr == 0) PG8_BAR; }
        if constexpr (!Epi::AFTER_DRAIN) { E(acc, cur, wr, wc, fr, fq); S.done(cur); }
        if (!has_next) break;
#pragma unroll
        for (int a = 0; a < 2; ++a)
#pragma unroll
            for (int b = 0; b < 2; ++b)
#pragma unroll
                for (int m = 0; m < 4; ++m)
#pragma unroll
                    for (int n = 0; n < 2; ++n) acc[a][b][m][n] = (f32x4){0.f, 0.f, 0.f, 0.f};
        cur = nxt; cA = nA; cB = nB; ++ui;
        if constexpr (ALIGN_EPI) { if (wr == 1) PG8_BAR; }
    }
    PG8_WAIT_V(0);
    if constexpr (!ALIGN_EPI) { if (wr == 0) PG8_BAR; }
    PG8_BAR;
    if constexpr (Epi::AFTER_DRAIN) { E.fused(acc, cur, wr, wc, fr, fq, lds, wid, lane); S.done(cur); }
#undef PG8_SA
#undef PG8_SB
#undef PG8_STAGE
#undef PG8_LDA
#undef PG8_LDB
#undef PG8_MMA
#undef PG8_WAIT_V
#undef PG8_WAIT_L
#undef PG8_BAR
#undef PG8_SCHED
}
}

constexpr int DM = 4096, TP = 16384, TS = 512, TT = TP + TS, SEQ = 8192, DFF = 11008, DIN = 9792, ZLD = 9984;
constexpr int KROWS = 25088;
constexpr int QLD = 3072, KNLD = 2048;
constexpr float EPSN = 1e-6f;
#ifndef MK_WGM_DOWN
#define MK_WGM_DOWN 2
#endif
#ifndef MK_YSCALE
#define MK_YSCALE 1.0f
#endif
constexpr float QSCALE = 0.07216878364870322f * 1.4426950408889634f;
constexpr size_t O_YP = 0, O_YS = 67108864, O_SRP = 69206016, O_CKP = 70254592, O_KRP = 78643200, O_SRS = 79691776, O_CKS = 83886080, O_KRS = 84148224, O_END = 84180992;
constexpr size_t MiB = 1u << 20;
constexpr size_t WS_CTL = 0, CTL_ZERO_BYTES = 1 * MiB;
constexpr size_t WS_W1GU = 1 * MiB;
constexpr size_t WS_W1D  = WS_W1GU + 172 * MiB;
constexpr size_t WS_KN   = WS_W1GU;
constexpr size_t WS_VT   = WS_W1GU + 98 * MiB;
constexpr size_t WS_W2GU = WS_W1D + 86 * MiB;
constexpr size_t WS_W2D  = WS_W2GU + 172 * MiB;
constexpr size_t WS_WIN  = WS_W2D + 86 * MiB;
constexpr size_t WS_WUQ  = WS_WIN + 78 * MiB;
constexpr size_t WS_WUK  = WS_WUQ + 6 * MiB;
constexpr size_t WS_WUV  = WS_WUK + 2 * MiB;
constexpr size_t WS_WOUT = WS_WUV + 2 * MiB;
constexpr size_t WS_XN   = WS_WOUT + 32 * MiB;
constexpr size_t WS_HID  = WS_XN + 132 * MiB;
constexpr size_t WS_Z    = WS_HID;
constexpr size_t WS_QAN  = WS_HID + 322 * MiB;
constexpr size_t WS_QH   = WS_HID + 355 * MiB;
constexpr size_t WS_CALL = WS_QH + 99 * MiB;
constexpr size_t WS_KR   = WS_CALL + 25 * MiB;
constexpr size_t WS_TAB  = WS_KR + 4 * MiB;
constexpr size_t WS_SLAB = WS_TAB + 10 * MiB;
constexpr size_t WS_HB   = WS_SLAB + 64 * MiB;
constexpr size_t WS_END  = WS_HB + 132 * MiB;
static_assert((size_t)TT * ZLD * 2 <= 322 * MiB && (size_t)TT * 1024 * 2 <= 33 * MiB && (size_t)TT * DFF * 2 <= 355 * MiB && (size_t)KROWS * 2048 * 2 <= 98 * MiB, "ws map");
constexpr int CW_QUEUE = 64;
constexpr int CW_BGQ = 2048;
constexpr int CW_BAR = 4096;
constexpr int RING_BYTES = 131072, MISC_OFF = RING_BYTES + 320, LDS_BYTES = 147456;

#define GAS __attribute__((address_space(1)))
#define LAS __attribute__((address_space(3)))
typedef unsigned short bf16;
typedef unsigned v4u __attribute__((ext_vector_type(4)));
typedef unsigned v2u __attribute__((ext_vector_type(2)));
typedef float f32x4 __attribute__((ext_vector_type(4)));
typedef float f32x16 __attribute__((ext_vector_type(16)));
typedef short bf16x8 __attribute__((ext_vector_type(8)));
typedef short s16x4 __attribute__((ext_vector_type(4)));
#define LDS_WAIT() asm volatile("s_waitcnt lgkmcnt(0)" ::: "memory")
#define VM_WAIT() asm volatile("s_waitcnt vmcnt(0)" ::: "memory")
__device__ __forceinline__ unsigned f2bf(float f) { unsigned u = __builtin_bit_cast(unsigned, f); return (u + 0x7fffu + ((u >> 16) & 1u)) >> 16; }
__device__ __forceinline__ unsigned pk2(float lo, float hi) { return pg8::cvt_pk_bf16(lo, hi); }
__device__ __forceinline__ float bflo(unsigned w) { return __builtin_bit_cast(float, w << 16); }
__device__ __forceinline__ float bfhi(unsigned w) { return __builtin_bit_cast(float, w & 0xffff0000u); }
__device__ __forceinline__ float ex2(float x) { return __builtin_amdgcn_exp2f(x); }
#define XB_TMO      128
#define XB_XCNT(j)  (256  + 64 * (j))
#define XB_XSUB(j)  (1280 + 64 * (j))
#define XB_XGEN(j)  (2304 + 64 * (j))
#define XB_TOP      3328
#define XB_TOPGEN   3392
#define XCD_BAR_WORDS 3456
#define XB_SPIN_CAP (1u << 18)

__device__ __forceinline__ unsigned xb_ld(unsigned* p)              { return __hip_atomic_load(p, __ATOMIC_RELAXED, __HIP_MEMORY_SCOPE_AGENT); }
__device__ __forceinline__ unsigned xb_add(unsigned* p, unsigned v) { return __hip_atomic_fetch_add(p, v, __ATOMIC_RELAXED, __HIP_MEMORY_SCOPE_AGENT); }
__device__ __forceinline__ unsigned xb_xcc_id() { return (unsigned)__builtin_amdgcn_s_getreg((3 << 11) | 20) & 0xFu; }
#define XB_SPIN(cond, bar) do { unsigned _sp = 0; while (cond) { __builtin_amdgcn_s_sleep(1); \
    if ((++_sp & 255u) == 0u) { if (xb_ld(&(bar)[XB_TMO])) break; if (_sp > XB_SPIN_CAP) { atomicAdd(&(bar)[XB_TMO], 1u); break; } } } } while (0)

struct XcdBarrier {
    unsigned* bar; unsigned x;
    volatile LAS unsigned* st;
};

__device__ __forceinline__ XcdBarrier xcd_barrier_post(unsigned* bar, volatile LAS unsigned* st) {
    XcdBarrier b; b.bar = bar; b.x = xb_xcc_id(); b.st = st;
    if (threadIdx.x == 0) (void)xb_add(&bar[XB_XCNT(b.x)], 1u);
    return b;
}
__device__ __forceinline__ void xcd_barrier_complete(unsigned* bar, unsigned x, unsigned& nloc, unsigned& nx) {
    const unsigned G = gridDim.x * gridDim.y * gridDim.z;
    unsigned sum, cnt, mine, sp = 0u;
    for (;;) {
        sum = 0u; cnt = 0u; mine = 0u;
#pragma unroll
        for (unsigned j = 0; j < 16; ++j) { const unsigned c = xb_ld(&bar[XB_XCNT(j)]); sum += c; cnt += (c > 0u) ? 1u : 0u; mine = (j == x) ? c : mine; }
        if (sum == G) break;
        __builtin_amdgcn_s_sleep(1);
        if ((++sp & 255u) == 0u) { if (xb_ld(&bar[XB_TMO])) break; if (sp > XB_SPIN_CAP) { atomicAdd(&bar[XB_TMO], 1u); break; } }
    }
    nloc = mine > 0u ? mine : 1u; nx = cnt > 0u ? cnt : 1u;
}

__device__ __forceinline__ void xcd_barrier(const XcdBarrier& b) {
    asm volatile("s_waitcnt vmcnt(0)" ::: "memory");
    __syncthreads();
    if (threadIdx.x == 0) {
        unsigned* bar = b.bar;
        __builtin_amdgcn_s_waitcnt(0);
        unsigned nloc = b.st[0], nx = b.st[1];
        if (nloc == 0u) { xcd_barrier_complete(bar, b.x, nloc, nx); b.st[0] = nloc; b.st[1] = nx; }
        const unsigned old = xb_add(&bar[XB_XSUB(b.x)], 1u);
        const unsigned gen = old / nloc;
        if (old + 1u == (gen + 1u) * nloc) {
            __builtin_amdgcn_fence(__ATOMIC_RELEASE, "agent");
            asm volatile("s_waitcnt vmcnt(0)" ::: "memory");
            const unsigned og = xb_add(&bar[XB_TOP], 1u);
            const unsigned tg = og / nx;
            if (og + 1u == (tg + 1u) * nx) xb_add(&bar[XB_TOPGEN], 1u);
            else XB_SPIN(xb_ld(&bar[XB_TOPGEN]) == tg, bar);
            __builtin_amdgcn_fence(__ATOMIC_ACQUIRE, "agent");
            xb_add(&bar[XB_XGEN(b.x)], 1u);
            asm volatile("s_waitcnt vmcnt(0)" ::: "memory");
        } else {
            XB_SPIN(xb_ld(&bar[XB_XGEN(b.x)]) == gen, bar);
            __builtin_amdgcn_fence(__ATOMIC_ACQUIRE, "agent");
            asm volatile("s_waitcnt vmcnt(0)" ::: "memory");
        }
    }
    __syncthreads();
}

__device__ __forceinline__ float wave_sum(float v) {
#pragma unroll
    for (int o = 1; o < 64; o <<= 1) v += __shfl_xor(v, o);
    return v;
}
__device__ __forceinline__ void tr_load(f32x4 (&wv)[8], const float* __restrict__ W, int N, int k0, int n0, int lane) {
#pragma unroll
    for (int i = 0; i < 8; ++i) wv[i] = __builtin_nontemporal_load((const GAS f32x4*)(W + (size_t)(k0 + 8 * i + (lane >> 3)) * N + n0 + 4 * (lane & 7)));
}
__device__ __forceinline__ void tr_store(const f32x4 (&wv)[8], int K, bf16* dst, LAS float* scr, int k0, int lane) {
#pragma unroll
    for (int i = 0; i < 8; ++i) { LAS float* d = scr + (8 * i + (lane >> 3)) * 33 + 4 * (lane & 7); d[0] = wv[i].x; d[1] = wv[i].y; d[2] = wv[i].z; d[3] = wv[i].w; }
    LDS_WAIT(); asm volatile("" ::: "memory");
    const int c = lane & 7;
#pragma unroll
    for (int j = 0; j < 4; ++j) { const int n = (lane >> 3) + 8 * j; const LAS float* s = scr + (8 * c) * 33 + n;
        v4u o; o.x = pk2(s[0 * 33], s[1 * 33]); o.y = pk2(s[2 * 33], s[3 * 33]); o.z = pk2(s[4 * 33], s[5 * 33]); o.w = pk2(s[6 * 33], s[7 * 33]);
        *(GAS v4u*)(dst + (size_t)n * K + k0 + 8 * c) = o; }
    LDS_WAIT(); asm volatile("" ::: "memory");
}
__device__ __forceinline__ void convert_decode(int K, int N, int mode, bf16* dstA, bf16* dstB, int it, int& k0, int& n0, bf16*& d) {
    const int nblk = N / 32;
    const int kb = it / nblk, nb = it - kb * nblk; n0 = 32 * nb; k0 = 64 * kb;
    if (mode == 0) d = dstA + (size_t)n0 * K;
    else if (mode == 1) d = dstA + (size_t)(256 * (n0 >> 7) + (n0 & 127)) * K;
    else if (mode == 2) d = dstA + (size_t)(256 * (n0 >> 7) + 128 + (n0 & 127)) * K;
    else { const int hh = n0 >> 8, x = n0 & 255; d = (x < 128) ? dstA + (size_t)(hh * 128 + x) * K : dstB + (size_t)(hh * 128 + x - 128) * K; }
}
__device__ __forceinline__ void convert_item(const float* __restrict__ W, int K, int N, int mode, bf16* dstA, bf16* dstB, LAS float* scr, int it, int lane) {
    int k0, n0; bf16* d; convert_decode(K, N, mode, dstA, dstB, it, k0, n0, d);
    f32x4 wv[8]; tr_load(wv, W, N, k0, n0, lane); tr_store(wv, K, d, scr, k0, lane);
}
__device__ __forceinline__ void convert_items4(const float* __restrict__ W, int K, int N, int mode, bf16* dstA, bf16* dstB, LAS float* scr, int it, int lane) {
    int k0[4], n0[4]; bf16* d[4]; f32x4 wv[4][8];
#pragma unroll
    for (int b = 0; b < 4; ++b) { convert_decode(K, N, mode, dstA, dstB, it + b, k0[b], n0[b], d[b]); tr_load(wv[b], W, N, k0[b], n0[b], lane); }
#pragma unroll
    for (int b = 0; b < 4; ++b) tr_store(wv[b], K, d[b], scr, k0[b], lane);
}
__device__ __forceinline__ void convert_weight(const float* __restrict__ W, int K, int N, int mode, bf16* dstA, bf16* dstB, LAS float* scr, int gw, int NGW, int lane) {
    const int nitems = (K / 64) * (N / 32);
    for (int it = gw; it < nitems; it += NGW) convert_item(W, K, N, mode, dstA, dstB, scr, it, lane);
}
__device__ __forceinline__ void sincos_tab(int pos, int i, int n, float& c, float& s) {
    const float inv = __builtin_exp2f(-(float)i * (13.287712379549449f / (float)n));
    const double ang = (double)pos * (double)inv;
    const double k = __builtin_rint(ang * 0.63661977236758134);
    const double r = (ang - k * 1.5707963267948966) - k * 6.123233995736766e-17;
    const double r2 = r * r;
    const double sn = r * (1.0 + r2 * (-1.0 / 6 + r2 * (1.0 / 120 + r2 * (-1.0 / 5040 + r2 * (1.0 / 362880 + r2 * (-1.0 / 39916800))))));
    const double cs = 1.0 + r2 * (-0.5 + r2 * (1.0 / 24 + r2 * (-1.0 / 720 + r2 * (1.0 / 40320 + r2 * (-1.0 / 3628800 + r2 * (1.0 / 479001600))))));
    const int q = ((int)k) & 3;
    const double cc = (q == 0) ? cs : (q == 1) ? -sn : (q == 2) ? -cs : sn;
    const double ss = (q == 0) ? sn : (q == 1) ? cs : (q == 2) ? -sn : -cs;
    c = (float)cc; s = (float)ss;
}
__device__ __forceinline__ void build_split_tab(LAS unsigned char* tab, int G, int K, int tid, int wgm) {
    for (int i = tid; i < 66 * 16; i += 512) tab[i] = 0xff;
    __syncthreads();
    pg8::SplitTailOrder S; S.init(TT, DM, G, 0, K); S.wgm = wgm; const int R = S.nwg / G, rem = S.nwg - R * G;
    if (tid < rem) { pg8::Unit u; S.tile(R * G + tid, u); tab[u.pm * 16 + u.pn] = (unsigned char)tid; }
    __syncthreads();
    if (tid < 66) { unsigned m = 0u;
        for (int j = 0; j < 16; ++j) m |= (tab[tid * 16 + j] != 0xff ? 1u : 0u) << j;
        ((LAS unsigned short*)(tab + 1088))[tid] = (unsigned short)m; }
    __syncthreads();
}
__device__ __forceinline__ void split_fixup(f32x4 (&v)[16], float* hrow, int r, const LAS unsigned char* tab, const float* __restrict__ slabs, float alpha, int lane) {
    const int pm = r >> 8;
#pragma unroll
    for (int j = 0; j < 16; ++j) {
        const int slot = __builtin_amdgcn_readfirstlane((int)tab[pm * 16 + j]);
        if (slot != 0xff) {
            const GAS f32x4* sp = (const GAS f32x4*)(slabs + (size_t)slot * 8 * 65536 + (size_t)(r & 255) * 256) + lane;
            f32x4 a = sp[0];
#pragma unroll
            for (int p = 1; p < 8; ++p) a = a + sp[(size_t)p * 16384];
            v[j] = v[j] + alpha * a;
            ((GAS f32x4*)hrow)[lane + 64 * j] = v[j];
        }
    }
}
template <bool FIX>
__device__ __forceinline__ void rms_row_bf16(float* xrow, const float* __restrict__ g, bf16* orow, int lane, int r, const LAS unsigned char* tab, const float* slabs, float alpha) {
    const GAS f32x4* xr = (const GAS f32x4*)xrow + lane;
    f32x4 v[16]; float s = 0.f;
#pragma unroll
    for (int j = 0; j < 16; ++j) v[j] = xr[64 * j];
    if (FIX) split_fixup(v, xrow, r, tab, slabs, alpha, lane);
#pragma unroll
    for (int j = 0; j < 16; ++j) s += (v[j].x * v[j].x + v[j].y * v[j].y) + (v[j].z * v[j].z + v[j].w * v[j].w);
    const float rinv = 1.0f / sqrtf(wave_sum(s) * (1.0f / 4096.0f) + EPSN);
    const GAS f32x4* gr = (const GAS f32x4*)g + lane;
    GAS v2u* o8 = (GAS v2u*)orow + lane;
#pragma unroll
    for (int j = 0; j < 16; ++j) { const f32x4 gv = gr[64 * j]; v2u w; w.x = pk2(v[j].x * rinv * gv.x, v[j].y * rinv * gv.y); w.y = pk2(v[j].z * rinv * gv.z, v[j].w * rinv * gv.w); o8[64 * j] = w; }
}
__device__ __forceinline__ void rms_row_f32_inplace(float* xrow, const float* __restrict__ g, int lane, int r, const LAS unsigned char* tab, const float* slabs, float alpha) {
    GAS f32x4* xr = (GAS f32x4*)xrow + lane;
    f32x4 v[16]; float s = 0.f;
#pragma unroll
    for (int j = 0; j < 16; ++j) v[j] = xr[64 * j];
    split_fixup(v, xrow, r, tab, slabs, alpha, lane);
#pragma unroll
    for (int j = 0; j < 16; ++j) s += (v[j].x * v[j].x + v[j].y * v[j].y) + (v[j].z * v[j].z + v[j].w * v[j].w);
    const float rinv = 1.0f / sqrtf(wave_sum(s) * (1.0f / 4096.0f) + EPSN);
    const GAS f32x4* gr = (const GAS f32x4*)g + lane;
#pragma unroll
    for (int j = 0; j < 16; ++j) { const f32x4 gv = gr[64 * j]; xr[64 * j] = v[j] * rinv * gv * MK_YSCALE; }
}
template <bool FIX, bool TO_BF16>
__device__ __forceinline__ void norm_phase(const float* x_p, const float* x_s  , const float* __restrict__ g, bf16* XNo, float* fout,
                                           int gw, int NGW, int lane, const LAS unsigned char* tab, const float* slabs, float alpha) {
    f32x4 gv[16], v[16], nx[16];
    constexpr bool W8 = TO_BF16 && !FIX;
#define NP_IDX(j) (W8 ? (2 * lane + 128 * ((j) >> 1) + ((j) & 1)) : (lane + 64 * (j)))
    { const GAS f32x4* gr = (const GAS f32x4*)g;
#pragma unroll
      for (int j = 0; j < 16; ++j) gv[j] = gr[NP_IDX(j)]; }
#define NP_LOAD(dst, rr) do { const GAS f32x4* xr_ = (const GAS f32x4*)((rr) < TP ? x_p + (size_t)(rr) * DM : x_s + (size_t)((rr) - TP) * DM); _Pragma("unroll") for (int j = 0; j < 16; ++j) dst[j] = __builtin_nontemporal_load(xr_ + NP_IDX(j)); } while (0)
    int r = gw;
    if (r < TT) NP_LOAD(v, r);
    for (; r < TT; r += NGW) {
        if (r + NGW < TT) NP_LOAD(nx, r + NGW);
        if (FIX) split_fixup(v, fout + (size_t)r * DM, r, tab, slabs, alpha, lane);
        float s = 0.f;
#pragma unroll
        for (int j = 0; j < 16; ++j) s += (v[j].x * v[j].x + v[j].y * v[j].y) + (v[j].z * v[j].z + v[j].w * v[j].w);
        const float rinv = 1.0f / sqrtf(wave_sum(s) * (1.0f / 4096.0f) + EPSN);
        if (W8) { GAS v4u* o16 = (GAS v4u*)(XNo + (size_t)r * DM) + lane;
#pragma unroll
            for (int jj = 0; jj < 8; ++jj) { const f32x4 a = v[2 * jj] * rinv * gv[2 * jj], b = v[2 * jj + 1] * rinv * gv[2 * jj + 1];
                v4u w; w.x = pk2(a.x, a.y); w.y = pk2(a.z, a.w); w.z = pk2(b.x, b.y); w.w = pk2(b.z, b.w); o16[64 * jj] = w; }
        } else if (TO_BF16) { GAS v2u* o8 = (GAS v2u*)(XNo + (size_t)r * DM) + lane;
#pragma unroll
            for (int j = 0; j < 16; ++j) { v2u w; w.x = pk2(v[j].x * rinv * gv[j].x, v[j].y * rinv * gv[j].y); w.y = pk2(v[j].z * rinv * gv[j].z, v[j].w * rinv * gv[j].w); o8[64 * j] = w; }
        } else { GAS f32x4* xr = (GAS f32x4*)(fout + (size_t)r * DM) + lane;
#pragma unroll
            for (int j = 0; j < 16; ++j) xr[64 * j] = v[j] * rinv * gv[j] * MK_YSCALE; }
#pragma unroll
        for (int j = 0; j < 16; ++j) v[j] = nx[j];
    }
#undef NP_LOAD
#undef NP_IDX
}
template <bool TO_BF16>
__device__ __forceinline__ void norm_phase_h(bf16* HB, const float* __restrict__ g, bf16* XNo, float* yout, int gw, int NGW, int lane, const LAS unsigned char* tab, const float* __restrict__ slabs, float alpha, int S) {
    f32x4 g0[8], g1[8]; v4u v[8], nx[8];
#pragma unroll
    for (int j = 0; j < 8; ++j) { const GAS f32x4* gp = (const GAS f32x4*)(g + 8 * (lane + 64 * j)); g0[j] = gp[0]; g1[j] = gp[1]; }
#define NH_LOAD(dst, rr) do { const GAS v4u* hr_ = (const GAS v4u*)(HB + (size_t)(rr) * DM) + lane; _Pragma("unroll") for (int j = 0; j < 8; ++j) dst[j] = hr_[64 * j]; } while (0)
    int r = gw;
    if (r < TT) NH_LOAD(v, r);
    for (; r < TT; r += NGW) {
        if (r + NGW < TT) NH_LOAD(nx, r + NGW);
        const int pm = r >> 8; float s = 0.f;
        const unsigned pmask = (unsigned)__builtin_amdgcn_readfirstlane((int)((const LAS unsigned short*)(tab + 1088))[pm]);
#pragma unroll
        for (int j = 0; j < 8; ++j) {
            f32x4 a0 = (f32x4){bflo(v[j].x), bfhi(v[j].x), bflo(v[j].y), bfhi(v[j].y)}, a1 = (f32x4){bflo(v[j].z), bfhi(v[j].z), bflo(v[j].w), bfhi(v[j].w)};
            if ((pmask >> (2 * j)) & 3u) {
                const int sl0 = __builtin_amdgcn_readfirstlane((int)tab[pm * 16 + 2 * j]), sl1 = __builtin_amdgcn_readfirstlane((int)tab[pm * 16 + 2 * j + 1]);
                const int slot = lane < 32 ? sl0 : sl1;
                if (slot != 0xff) {
                    const GAS v4u* sp = (const GAS v4u*)((const bf16*)slabs + (size_t)slot * S * 65536 + (size_t)(r & 255) * 256 + 8 * (lane & 31));
                    v4u pw[8];
#pragma unroll
                    for (int p = 0; p < 8; ++p) if (p < S) pw[p] = sp[(size_t)p * 8192];
                    f32x4 p0 = (f32x4){bflo(pw[0].x), bfhi(pw[0].x), bflo(pw[0].y), bfhi(pw[0].y)}, p1 = (f32x4){bflo(pw[0].z), bfhi(pw[0].z), bflo(pw[0].w), bfhi(pw[0].w)};
#pragma unroll
                    for (int p = 1; p < 8; ++p) if (p < S) { p0 = p0 + (f32x4){bflo(pw[p].x), bfhi(pw[p].x), bflo(pw[p].y), bfhi(pw[p].y)}; p1 = p1 + (f32x4){bflo(pw[p].z), bfhi(pw[p].z), bflo(pw[p].w), bfhi(pw[p].w)}; }
                    a0 = a0 + alpha * p0; a1 = a1 + alpha * p1;
                    v4u w; w.x = pk2(a0.x, a0.y); w.y = pk2(a0.z, a0.w); w.z = pk2(a1.x, a1.y); w.w = pk2(a1.z, a1.w);
                    ((GAS v4u*)(HB + (size_t)r * DM))[lane + 64 * j] = w;
                    a0 = (f32x4){bflo(w.x), bfhi(w.x), bflo(w.y), bfhi(w.y)}; a1 = (f32x4){bflo(w.z), bfhi(w.z), bflo(w.w), bfhi(w.w)};
                    v[j] = w;
                }
            }
            s += (a0.x * a0.x + a0.y * a0.y) + (a0.z * a0.z + a0.w * a0.w) + (a1.x * a1.x + a1.y * a1.y) + (a1.z * a1.z + a1.w * a1.w);
        }
        const float rinv = 1.0f / sqrtf(wave_sum(s) * (1.0f / 4096.0f) + EPSN);
#pragma unroll
        for (int j = 0; j < 8; ++j) {
            const f32x4 o0 = (f32x4){bflo(v[j].x), bfhi(v[j].x), bflo(v[j].y), bfhi(v[j].y)} * rinv * g0[j], o1 = (f32x4){bflo(v[j].z), bfhi(v[j].z), bflo(v[j].w), bfhi(v[j].w)} * rinv * g1[j];
            if (TO_BF16) { v4u w; w.x = pk2(o0.x, o0.y); w.y = pk2(o0.z, o0.w); w.z = pk2(o1.x, o1.y); w.w = pk2(o1.z, o1.w); ((GAS v4u*)(XNo + (size_t)r * DM))[lane + 64 * j] = w; }
            else { GAS f32x4* yp = (GAS f32x4*)(yout + (size_t)r * DM + 8 * (lane + 64 * j)); yp[0] = o0 * MK_YSCALE; yp[1] = o1 * MK_YSCALE; }
        }
#pragma unroll
        for (int j = 0; j < 8; ++j) v[j] = nx[j];
    }
#undef NH_LOAD
}
__device__ __forceinline__ void norm_phase_y(bf16* HB, const float* __restrict__ g, float* yout, int gw, int NGW, int lane, const LAS unsigned char* tab, const float* __restrict__ slabs, float alpha, int S) {
    f32x4 gg[16]; v2u v[16], nx[16];
#pragma unroll
    for (int jj = 0; jj < 16; ++jj) gg[jj] = *(const GAS f32x4*)(g + 256 * jj + 4 * lane);
#define NY_LOAD(dst, rr) do { const GAS v2u* hr_ = (const GAS v2u*)(HB + (size_t)(rr) * DM) + lane; _Pragma("unroll") for (int jj = 0; jj < 16; ++jj) dst[jj] = __builtin_nontemporal_load(hr_ + 64 * jj); } while (0)
    int r = gw;
    if (r < TT) NY_LOAD(v, r);
    for (; r < TT; r += NGW) {
        if (r + NGW < TT) NY_LOAD(nx, r + NGW);
        const int pm = r >> 8; float s = 0.f;
        const unsigned pmask = (unsigned)__builtin_amdgcn_readfirstlane((int)((const LAS unsigned short*)(tab + 1088))[pm]);
#pragma unroll
        for (int jj = 0; jj < 16; ++jj) {
            f32x4 a = (f32x4){bflo(v[jj].x), bfhi(v[jj].x), bflo(v[jj].y), bfhi(v[jj].y)};
            if ((pmask >> jj) & 1u) {
                const int slot = __builtin_amdgcn_readfirstlane((int)tab[pm * 16 + jj]);
                const GAS v2u* sp = (const GAS v2u*)((const bf16*)slabs + (size_t)slot * S * 65536 + (size_t)(r & 255) * 256 + 4 * lane);
                f32x4 ps = (f32x4){0.f, 0.f, 0.f, 0.f};
#pragma unroll
                for (int p = 0; p < 8; ++p) if (p < S) { const v2u w = sp[(size_t)p * 16384]; ps = ps + (f32x4){bflo(w.x), bfhi(w.x), bflo(w.y), bfhi(w.y)}; }
                a = a + alpha * ps;
                v2u w; w.x = pk2(a.x, a.y); w.y = pk2(a.z, a.w);
                ((GAS v2u*)(HB + (size_t)r * DM))[lane + 64 * jj] = w;
                a = (f32x4){bflo(w.x), bfhi(w.x), bflo(w.y), bfhi(w.y)}; v[jj] = w;
            }
            s += (a.x * a.x + a.y * a.y) + (a.z * a.z + a.w * a.w);
        }
        const float rinv = 1.0f / sqrtf(wave_sum(s) * (1.0f / 4096.0f) + EPSN);
#pragma unroll
        for (int jj = 0; jj < 16; ++jj) { const f32x4 o = (f32x4){bflo(v[jj].x), bfhi(v[jj].x), bflo(v[jj].y), bfhi(v[jj].y)} * rinv * gg[jj];
            __builtin_nontemporal_store(o * MK_YSCALE, (GAS f32x4*)(yout + (size_t)r * DM + 256 * jj + 4 * lane)); }
#pragma unroll
        for (int jj = 0; jj < 16; ++jj) v[jj] = nx[jj];
    }
#undef NY_LOAD
}
__device__ __forceinline__ int pos_of_row(int r) { return r < TP ? (r & (SEQ - 1)) : 1024 + ((r - TP) & 63); }
__device__ __forceinline__ int crow_of_row(int r) { return r < TP ? r : TP + 1088 * ((r - TP) >> 6) + 1024 + ((r - TP) & 63); }

typedef short v4i16_t __attribute__((ext_vector_type(4)));
__device__ __forceinline__ bf16x8 tr_frag(const LAS unsigned char* img, int stride, int row0, int col0, int li, int q4) {
    const LAS unsigned char* p = img + (row0 + 8 * q4 + (li >> 2)) * stride + (col0 + 4 * (li & 3)) * 2;
    const v4i16_t a = __builtin_amdgcn_ds_read_tr16_b64_v4i16((LAS v4i16_t*)p);
    const v4i16_t b = __builtin_amdgcn_ds_read_tr16_b64_v4i16((LAS v4i16_t*)(p + 4 * stride));
    bf16x8 r; r[0] = a[0]; r[1] = a[1]; r[2] = a[2]; r[3] = a[3]; r[4] = b[0]; r[5] = b[1]; r[6] = b[2]; r[7] = b[3]; return r;
}

constexpr int R_QS = 0, R_KS = 33792, R_VS = 67584, R_V2 = 84992, R_PS = 102400, R_QSTR = 528, R_VSTR = 272, R_PSTR = 144;
__device__ __forceinline__ void ret_unit(LAS unsigned char* lds, int kind, int bidx, int h, int half, const bf16* __restrict__ Z, bf16* OM, const float* __restrict__ S0, float* Sout, int tid) {
    const int wid = __builtin_amdgcn_readfirstlane(tid >> 6), lane = tid & 63, li = lane & 15, q4 = lane >> 4;
    const int nchunks = kind == 0 ? 128 : 1;
    const int row0 = kind == 0 ? bidx * SEQ : TP + 64 * bidx;
    const float lg = __builtin_log2f(1.0f - ex2(-5.0f - (float)h));
    const int cw = 128 * half + 16 * wid;
    f32x4 S[16];
    if (kind == 0) {
#pragma unroll
        for (int j = 0; j < 16; ++j) S[j] = (f32x4){0.f, 0.f, 0.f, 0.f};
    } else {
        const float* sp = S0 + ((size_t)(bidx * 8 + h) * 256) * 256 + cw + li;
#pragma unroll
        for (int j = 0; j < 16; ++j)
#pragma unroll
            for (int r = 0; r < 4; ++r) S[j][r] = sp[(size_t)(16 * j + 4 * q4 + r) * 256];
    }
    v4u rq[4], rk[4], rv[2];
    const int qrow = tid >> 5, qc = tid & 31, vrow = tid >> 4, vc = tid & 15;
#define RET_LOAD(c) do { const bf16* zb = Z + (size_t)(row0 + 64 * (c)) * ZLD + h * 256; \
        _Pragma("unroll") for (int i = 0; i < 4; ++i) { rq[i] = *(const GAS v4u*)(zb + (size_t)(qrow + 16 * i) * ZLD + 8 * qc); rk[i] = *(const GAS v4u*)(zb + (size_t)(qrow + 16 * i) * ZLD + 2048 + 8 * qc); } \
        _Pragma("unroll") for (int i = 0; i < 2; ++i) rv[i] = *(const GAS v4u*)(zb + (size_t)(vrow + 32 * i) * ZLD + 4096 + 128 * half + 8 * vc); } while (0)
    RET_LOAD(0);
    const float g64 = ex2(64.0f * lg);
    for (int c = 0; c < nchunks; ++c) {
        __syncthreads();
#pragma unroll
        for (int i = 0; i < 4; ++i) { *(LAS v4u*)(lds + R_QS + (qrow + 16 * i) * R_QSTR + 16 * qc) = rq[i]; *(LAS v4u*)(lds + R_KS + (qrow + 16 * i) * R_QSTR + 16 * qc) = rk[i]; }
#pragma unroll
        for (int i = 0; i < 2; ++i) { const int row = vrow + 32 * i; *(LAS v4u*)(lds + R_VS + row * R_VSTR + 16 * vc) = rv[i];
            const float sc = ex2((float)(63 - row) * lg); v4u w;
            w.x = pk2(bflo(rv[i].x) * sc, bfhi(rv[i].x) * sc); w.y = pk2(bflo(rv[i].y) * sc, bfhi(rv[i].y) * sc); w.z = pk2(bflo(rv[i].z) * sc, bfhi(rv[i].z) * sc); w.w = pk2(bflo(rv[i].w) * sc, bfhi(rv[i].w) * sc);
            *(LAS v4u*)(lds + R_V2 + row * R_VSTR + 16 * vc) = w; }
        __syncthreads();
        if (c + 1 < nchunks) RET_LOAD(c + 1);
        {
            const int bi = wid >> 1, bj0 = 2 * (wid & 1);
            f32x4 p0 = (f32x4){0.f, 0.f, 0.f, 0.f}, p1 = p0;
#pragma unroll
            for (int ks = 0; ks < 8; ++ks) {
                const bf16x8 a = *(const LAS bf16x8*)(lds + R_QS + (16 * bi + li) * R_QSTR + (32 * ks + 8 * q4) * 2);
                const bf16x8 b0 = *(const LAS bf16x8*)(lds + R_KS + (16 * bj0 + li) * R_QSTR + (32 * ks + 8 * q4) * 2);
                const bf16x8 b1 = *(const LAS bf16x8*)(lds + R_KS + (16 * bj0 + 16 + li) * R_QSTR + (32 * ks + 8 * q4) * 2);
                p0 = __builtin_amdgcn_mfma_f32_16x16x32_bf16(a, b0, p0, 0, 0, 0);
                p1 = __builtin_amdgcn_mfma_f32_16x16x32_bf16(a, b1, p1, 0, 0, 0);
            }
#pragma unroll
            for (int r = 0; r < 4; ++r) { const int l = 16 * bi + 4 * q4 + r, m0 = 16 * bj0 + li, m1 = m0 + 16;
                const float v0 = (l >= m0) ? p0[r] * ex2((float)(l - m0) * lg) : 0.f, v1 = (l >= m1) ? p1[r] * ex2((float)(l - m1) * lg) : 0.f;
                *(LAS unsigned short*)(lds + R_PS + l * R_PSTR + m0 * 2) = (unsigned short)f2bf(v0);
                *(LAS unsigned short*)(lds + R_PS + l * R_PSTR + m1 * 2) = (unsigned short)f2bf(v1); }
        }
        __syncthreads();
        {
            f32x4 o[4];
#pragma unroll
            for (int tb = 0; tb < 4; ++tb) o[tb] = (f32x4){0.f, 0.f, 0.f, 0.f};
#pragma unroll
            for (int ks = 0; ks < 8; ++ks) {
                v4u sw; sw.x = pk2(S[2 * ks][0], S[2 * ks][1]); sw.y = pk2(S[2 * ks][2], S[2 * ks][3]); sw.z = pk2(S[2 * ks + 1][0], S[2 * ks + 1][1]); sw.w = pk2(S[2 * ks + 1][2], S[2 * ks + 1][3]);
                const bf16x8 sb = __builtin_bit_cast(bf16x8, sw);
#pragma unroll
                for (int tb = 0; tb < 4; ++tb) {
                    const v2u lo = *(const LAS v2u*)(lds + R_QS + (16 * tb + li) * R_QSTR + (32 * ks + 4 * q4) * 2);
                    const v2u hi = *(const LAS v2u*)(lds + R_QS + (16 * tb + li) * R_QSTR + (32 * ks + 16 + 4 * q4) * 2);
                    v4u w; w.x = lo.x; w.y = lo.y; w.z = hi.x; w.w = hi.y;
                    o[tb] = __builtin_amdgcn_mfma_f32_16x16x32_bf16(sb, __builtin_bit_cast(bf16x8, w), o[tb], 0, 0, 0);
                }
            }
            const bf16x8 vf0 = tr_frag(lds + R_VS, R_VSTR, 0, 16 * wid, li, q4), vf1 = tr_frag(lds + R_VS, R_VSTR, 32, 16 * wid, li, q4);
#pragma unroll
            for (int tb = 0; tb < 4; ++tb) {
                o[tb] = o[tb] * ex2((float)(16 * tb + li + 1) * lg);
                const bf16x8 pa0 = *(const LAS bf16x8*)(lds + R_PS + (16 * tb + li) * R_PSTR + (8 * q4) * 2);
                const bf16x8 pa1 = *(const LAS bf16x8*)(lds + R_PS + (16 * tb + li) * R_PSTR + (32 + 8 * q4) * 2);
                o[tb] = __builtin_amdgcn_mfma_f32_16x16x32_bf16(vf0, pa0, o[tb], 0, 0, 0);
                o[tb] = __builtin_amdgcn_mfma_f32_16x16x32_bf16(vf1, pa1, o[tb], 0, 0, 0);
                v2u ow; ow.x = pk2(o[tb][0], o[tb][1]); ow.y = pk2(o[tb][2], o[tb][3]);
                *(GAS v2u*)(OM + (size_t)(row0 + 64 * c + 16 * tb + li) * DM + h * 256 + cw + 4 * q4) = ow;
            }
        }
        {
            const bf16x8 wf0 = tr_frag(lds + R_V2, R_VSTR, 0, 16 * wid, li, q4), wf1 = tr_frag(lds + R_V2, R_VSTR, 32, 16 * wid, li, q4);
#pragma unroll
            for (int j = 0; j < 16; ++j) {
                S[j] = S[j] * g64;
                const bf16x8 k0 = tr_frag(lds + R_KS, R_QSTR, 0, 16 * j, li, q4), k1 = tr_frag(lds + R_KS, R_QSTR, 32, 16 * j, li, q4);
                S[j] = __builtin_amdgcn_mfma_f32_16x16x32_bf16(k0, wf0, S[j], 0, 0, 0);
                S[j] = __builtin_amdgcn_mfma_f32_16x16x32_bf16(k1, wf1, S[j], 0, 0, 0);
            }
        }
    }
#undef RET_LOAD
    float* so = Sout + cw + li;
#pragma unroll
    for (int j = 0; j < 16; ++j)
#pragma unroll
        for (int r = 0; r < 4; ++r) so[(size_t)(16 * j + 4 * q4 + r) * 256] = S[j][r];
}

constexpr int A_NSTR = 272, A_RSTR = 144, A_VSTR = 144, A_KN = 64 * A_NSTR  , A_KR = 64 * A_RSTR  , A_KB = A_KN + A_KR  , A_VB = 128 * A_VSTR  , A_V0 = 3 * A_KB;
constexpr int A_NI_N = 17, A_NI_R = 9, A_NI_V = 18, A_NI = A_NI_N + A_NI_R + A_NI_V;
static_assert(A_KN == A_NI_N * 1024 && A_KR == A_NI_R * 1024 && A_VB == A_NI_V * 1024 && A_V0 + 2 * A_VB <= RING_BYTES, "attention LDS map");
__device__ __forceinline__ void attn_qk(f32x16& p, const LAS unsigned char* kb, int half, const bf16x8 (&q)[12], int n32, int hi) {
#pragma unroll
    for (int r = 0; r < 16; ++r) p[r] = 0.f;
    bf16x8 a[12];
#pragma unroll
    for (int ks = 0; ks < 8; ++ks) a[ks] = *(const LAS bf16x8*)(kb + (32 * half + n32) * A_NSTR + (16 * ks + 8 * hi) * 2);
#pragma unroll
    for (int ks = 0; ks < 4; ++ks) a[8 + ks] = *(const LAS bf16x8*)(kb + A_KN + (32 * half + n32) * A_RSTR + (16 * ks + 8 * hi) * 2);
#pragma unroll
    for (int ks = 0; ks < 12; ++ks) p = __builtin_amdgcn_mfma_f32_32x32x16_bf16(a[ks], q[ks], p, 0, 0, 0);
}
__device__ __forceinline__ float attn_softmax(f32x16& p, float& m_run, float& l_run, bf16x8 (&pa)[2]) {
    float pmax = p[0];
#pragma unroll
    for (int r = 1; r < 16; ++r) pmax = fmaxf(pmax, p[r]);
    { auto rr = __builtin_amdgcn_permlane32_swap(__float_as_uint(pmax), __float_as_uint(pmax), false, false); pmax = fmaxf(__uint_as_float(rr[0]), __uint_as_float(rr[1])); }
    const bool need = (pmax - m_run) > 10.0f;
    const float mn = need ? pmax : m_run, alpha = ex2(m_run - mn); m_run = mn;
    float ps = 0.f;
#pragma unroll
    for (int r = 0; r < 16; ++r) { p[r] = ex2(p[r] - mn); ps += p[r]; }
    { auto rr = __builtin_amdgcn_permlane32_swap(__float_as_uint(ps), __float_as_uint(ps), false, false); ps = __uint_as_float(rr[0]) + __uint_as_float(rr[1]); }
    l_run = l_run * alpha + ps;
#define PK4(P, B_, OUT) do { const unsigned a0_ = pk2(P[B_ + 0], P[B_ + 1]), a1_ = pk2(P[B_ + 2], P[B_ + 3]), b0_ = pk2(P[B_ + 4], P[B_ + 5]), b1_ = pk2(P[B_ + 6], P[B_ + 7]); \
    auto r0_ = __builtin_amdgcn_permlane32_swap(a0_, b0_, false, false); auto r1_ = __builtin_amdgcn_permlane32_swap(a1_, b1_, false, false); \
    v4u w_; w_.x = r0_[0]; w_.y = r1_[0]; w_.z = r0_[1]; w_.w = r1_[1]; OUT = __builtin_bit_cast(bf16x8, w_); } while (0)
    PK4(p, 0, pa[0]); PK4(p, 8, pa[1]);
#undef PK4
    return alpha;
}
__device__ __forceinline__ void attn_pv(f32x16 (&O)[4], const LAS unsigned char* vbh  , const bf16x8 (&pa)[2], float alpha, int n32, int hi) {
    if (__any(alpha != 1.0f)) {
#pragma unroll
        for (int cb = 0; cb < 4; ++cb)
#pragma unroll
            for (int r = 0; r < 16; ++r) O[cb][r] *= alpha;
    }
    bf16x8 v[4][2];
#pragma unroll
    for (int cb = 0; cb < 4; ++cb)
#pragma unroll
        for (int ks = 0; ks < 2; ++ks) v[cb][ks] = *(const LAS bf16x8*)(vbh + (32 * cb + n32) * A_VSTR + (16 * ks + 8 * hi) * 2);
#pragma unroll
    for (int ks = 0; ks < 2; ++ks)
#pragma unroll
        for (int cb = 0; cb < 4; ++cb) O[cb] = __builtin_amdgcn_mfma_f32_32x32x16_bf16(v[cb][ks], pa[ks], O[cb], 0, 0, 0);
}
#define ATT_SCHED() do { __builtin_amdgcn_sched_group_barrier(0x100, 12, 0); _Pragma("unroll") for (int i_ = 0; i_ < 12; ++i_) { __builtin_amdgcn_sched_group_barrier(0x008, 1, 0); __builtin_amdgcn_sched_group_barrier(0x002, 9, 0); } } while (0)
__device__ __forceinline__ void attn_unit(LAS unsigned char* lds, int qrow0, int nqw, int krow0, int ntiles, int wt_base, int h,
                                          const bf16* __restrict__ QH, const bf16* __restrict__ KN, const bf16* __restrict__ KR, const bf16* __restrict__ VT, bf16* OM, int tid,
                                          const float* __restrict__ gqn, const float* __restrict__ gqr, const float* __restrict__ mcos, const float* __restrict__ msin) {
    const int wid = __builtin_amdgcn_readfirstlane(tid >> 6), lane = tid & 63, n32 = lane & 31, hi = lane >> 5;
    const bool active = wid < nqw;
    const int my_tiles = !active ? 0 : (wt_base < 0 ? ntiles : wt_base + (wid >> 1) + 1);
    f32x16 O[4];
#pragma unroll
    for (int cb = 0; cb < 4; ++cb)
#pragma unroll
        for (int r = 0; r < 16; ++r) O[cb][r] = 0.f;
    float m_run = -1e30f, l_run = 0.f;
    unsigned doff[6];
#pragma unroll
    for (int k = 0; k < 6; ++k) { const int sl = wid + 8 * k;
        if (sl < A_NI_N) { const int pp = 64 * sl + lane, row = pp / 17, c = pp - 17 * row; doff[k] = (unsigned)(row * (KNLD * 2) + h * 256 + (c < 16 ? c : 15) * 16); }
        else if (sl < A_NI_N + A_NI_R) { const int pp = 64 * (sl - A_NI_N) + lane, row = pp / 9, c = pp - 9 * row; doff[k] = (unsigned)(row * 128 + (c < 8 ? c : 7) * 16); }
        else { const int pp = 64 * (sl - A_NI_N - A_NI_R) + lane, row = pp / 9, c = pp - 9 * row; doff[k] = (unsigned)((h * 128 + row) * (KROWS * 2) + (c < 8 ? c : 7) * 16); } }
    const int tlast = ntiles - 1;
#define ATT_DMA_K(t, kbi) do { const int jj_ = (t) < tlast ? (t) : tlast; const size_t kr0_ = (size_t)krow0 + 64 * (size_t)jj_; \
        _Pragma("unroll") for (int k = 0; k < 4; ++k) { const int sl = wid + 8 * k; \
            if (sl < A_NI_N) __builtin_amdgcn_global_load_lds((const unsigned*)((const char*)KN + kr0_ * (KNLD * 2) + doff[k]), (LAS unsigned*)(lds + (kbi) * A_KB + sl * 1024), 16, 0, 0); \
            else if (sl < A_NI_N + A_NI_R) __builtin_amdgcn_global_load_lds((const unsigned*)((const char*)KR + kr0_ * 128 + doff[k]), (LAS unsigned*)(lds + (kbi) * A_KB + A_KN + (sl - A_NI_N) * 1024), 16, 0, 0); } } while (0)
#define ATT_DMA_V(t, vbi) do { const int jj_ = (t) < tlast ? (t) : tlast; const size_t kr0_ = (size_t)krow0 + 64 * (size_t)jj_; \
        _Pragma("unroll") for (int k = 3; k < 6; ++k) { const int sl = wid + 8 * k; \
            if (sl >= A_NI_N + A_NI_R && sl < A_NI) __builtin_amdgcn_global_load_lds((const unsigned*)((const char*)VT + kr0_ * 2 + doff[k]), (LAS unsigned*)(lds + A_V0 + (vbi) * A_VB + (sl - A_NI_N - A_NI_R) * 1024), 16, 0, 0); } } while (0)
    __syncthreads();
    ATT_DMA_K(0, 0); ATT_DMA_V(0, 0); ATT_DMA_K(1, 1);
    bf16x8 q[12];
    {
        const int qrow = qrow0 + 32 * (active ? wid : 0) + n32;
        const bf16* qp = QH + (size_t)qrow * QLD + h * 192 + 8 * hi;
        v4u qv[12];
#pragma unroll
        for (int ks = 0; ks < 12; ++ks) qv[ks] = *(const GAS v4u*)(qp + 16 * ks);
        float sn = 0.f, sr = 0.f;
#pragma unroll
        for (int ks = 0; ks < 12; ++ks) { const float a0 = bflo(qv[ks].x), a1 = bfhi(qv[ks].x), a2 = bflo(qv[ks].y), a3 = bfhi(qv[ks].y), a4 = bflo(qv[ks].z), a5 = bfhi(qv[ks].z), a6 = bflo(qv[ks].w), a7 = bfhi(qv[ks].w);
            const float t = (a0 * a0 + a1 * a1) + (a2 * a2 + a3 * a3) + (a4 * a4 + a5 * a5) + (a6 * a6 + a7 * a7); if (ks < 8) sn += t; else sr += t; }
        sn += __shfl_xor(sn, 32); sr += __shfl_xor(sr, 32);
        const float rn = QSCALE / sqrtf(sn * (1.0f / 128.0f) + EPSN), rr = 1.0f / sqrtf(sr * (1.0f / 64.0f) + EPSN);
#pragma unroll
        for (int ks = 0; ks < 8; ++ks) { const GAS f32x4* gp = (const GAS f32x4*)(gqn + 16 * ks + 8 * hi); const f32x4 ga = gp[0], gb = gp[1]; const v4u r = qv[ks]; v4u w;
            w.x = pk2(bflo(r.x) * rn * ga.x, bfhi(r.x) * rn * ga.y); w.y = pk2(bflo(r.y) * rn * ga.z, bfhi(r.y) * rn * ga.w);
            w.z = pk2(bflo(r.z) * rn * gb.x, bfhi(r.z) * rn * gb.y); w.w = pk2(bflo(r.w) * rn * gb.z, bfhi(r.w) * rn * gb.w); qv[ks] = w; asm volatile("" : "+v"(qv[ks])); }
        const int pos = pos_of_row(qrow);
#pragma unroll
        for (int kk = 0; kk < 2; ++kk) {
            const int d0 = 16 * kk + 8 * hi;
            const GAS float* g1p = (const GAS float*)(gqr + d0); const GAS float* g2p = (const GAS float*)(gqr + 32 + d0);
            const GAS float* cp = (const GAS float*)(mcos + pos * 32 + d0); const GAS float* sp = (const GAS float*)(msin + pos * 32 + d0);
            const v4u r1 = qv[8 + kk], r2 = qv[10 + kk]; unsigned w1[4], w2[4];
            const unsigned r1a[4] = {r1.x, r1.y, r1.z, r1.w}, r2a[4] = {r2.x, r2.y, r2.z, r2.w};
#pragma unroll
            for (int i = 0; i < 4; ++i) {
                const float ya = bflo(r1a[i]) * rr * g1p[2 * i], yb = bfhi(r1a[i]) * rr * g1p[2 * i + 1], za = bflo(r2a[i]) * rr * g2p[2 * i], zb = bfhi(r2a[i]) * rr * g2p[2 * i + 1];
                const float ca = cp[2 * i], cb = cp[2 * i + 1], sa = sp[2 * i], sb = sp[2 * i + 1];
                w1[i] = pk2((ya * ca - za * sa) * QSCALE, (yb * cb - zb * sb) * QSCALE); w2[i] = pk2((za * ca + ya * sa) * QSCALE, (zb * cb + yb * sb) * QSCALE); }
            qv[8 + kk] = (v4u){w1[0], w1[1], w1[2], w1[3]}; qv[10 + kk] = (v4u){w2[0], w2[1], w2[2], w2[3]};
        }
#pragma unroll
        for (int ks = 0; ks < 12; ++ks) q[ks] = __builtin_bit_cast(bf16x8, qv[ks]);
    }
    __builtin_amdgcn_sched_barrier(0);
    VM_WAIT(); __syncthreads();
    f32x16 p;
    if (wid >= 4) __builtin_amdgcn_s_setprio(1);
    if (0 < my_tiles) attn_qk(p, lds, 0, q, n32, hi);
    int j = 0, kc = 0;
    for (; j + 1 < my_tiles; ++j) {
        const int k1 = kc == 2 ? 0 : kc + 1, k2 = k1 == 2 ? 0 : k1 + 1;
        ATT_DMA_K(j + 2, k2); ATT_DMA_V(j + 1, (j + 1) & 1);
        const LAS unsigned char* kb = lds + kc * A_KB; const LAS unsigned char* kn = lds + k1 * A_KB; const LAS unsigned char* vb = lds + A_V0 + (j & 1) * A_VB;
        { f32x16 n; bf16x8 pa[2];
          attn_qk(n, kb, 1, q, n32, hi);
          const float alpha = attn_softmax(p, m_run, l_run, pa);
          ATT_SCHED();
          attn_pv(O, vb, pa, alpha, n32, hi);
          p = n; }
        { f32x16 n; bf16x8 pa[2];
          attn_qk(n, kn, 0, q, n32, hi);
          const float alpha = attn_softmax(p, m_run, l_run, pa);
          ATT_SCHED();
          attn_pv(O, vb + 64, pa, alpha, n32, hi);
          p = n; }
        VM_WAIT(); __syncthreads();
        kc = k1;
    }
    if (j < my_tiles) {
        const int k1 = kc == 2 ? 0 : kc + 1, k2 = k1 == 2 ? 0 : k1 + 1;
        ATT_DMA_K(j + 2, k2); ATT_DMA_V(j + 1, (j + 1) & 1);
        const LAS unsigned char* kb = lds + kc * A_KB; const LAS unsigned char* vb = lds + A_V0 + (j & 1) * A_VB;
        { f32x16 n; bf16x8 pa[2];
          attn_qk(n, kb, 1, q, n32, hi);
          const float alpha = attn_softmax(p, m_run, l_run, pa);
          ATT_SCHED();
          attn_pv(O, vb, pa, alpha, n32, hi);
          p = n; }
        { bf16x8 pa[2];
          const float alpha = attn_softmax(p, m_run, l_run, pa);
          attn_pv(O, vb + 64, pa, alpha, n32, hi); }
        VM_WAIT(); __syncthreads();
        kc = k1; ++j;
    }
    for (; j < ntiles; ++j) {
        const int k1 = kc == 2 ? 0 : kc + 1, k2 = k1 == 2 ? 0 : k1 + 1;
        ATT_DMA_K(j + 2, k2); ATT_DMA_V(j + 1, (j + 1) & 1);
        VM_WAIT(); __syncthreads();
        kc = k1;
    }
#undef ATT_DMA_K
#undef ATT_DMA_V
    __builtin_amdgcn_s_setprio(0);
    if (active) {
        const float il = 1.0f / l_run;
        unsigned char* orow = (unsigned char*)(OM + (size_t)(qrow0 + 32 * wid + n32) * DM + 2048 + h * 128) + (hi ? 16 : 0);
#pragma unroll
        for (int k = 0; k < 16; k += 2) { const int cb = k >> 2, g = k & 3;
            unsigned ax = pk2(O[cb][4 * g] * il, O[cb][4 * g + 1] * il), ay = pk2(O[cb][4 * g + 2] * il, O[cb][4 * g + 3] * il);
            unsigned bx = pk2(O[cb][4 * g + 4] * il, O[cb][4 * g + 5] * il), by = pk2(O[cb][4 * g + 6] * il, O[cb][4 * g + 7] * il);
            { auto r = __builtin_amdgcn_permlane32_swap(ax, bx, false, false); ax = r[0]; bx = r[1]; }
            { auto r = __builtin_amdgcn_permlane32_swap(ay, by, false, false); ay = r[0]; by = r[1]; }
            *(GAS v4u*)(orow + 16 * k) = (v4u){ax, ay, bx, by}; }
    }
}

constexpr int NWAVES = 8;
constexpr int N_PHASES = 15;
struct Args { const float* in[26]; float* out; unsigned char* ws; int ph_lo, ph_hi, li, pad1; };
__global__ void __launch_bounds__(NWAVES * 64, 2) mk_fwd(Args args) {
    extern __shared__ __attribute__((aligned(16))) unsigned char lds_raw[];
    LAS unsigned char* lds = (LAS unsigned char*)lds_raw;
    volatile LAS unsigned* MISC = (volatile LAS unsigned*)(lds + MISC_OFF);
    const int tid = threadIdx.x, lane = tid & 63, wave = __builtin_amdgcn_readfirstlane(tid >> 6);
    const int G = gridDim.x;
    const int gw = blockIdx.x * NWAVES + wave, NGW = G * NWAVES;
    unsigned char* ws = args.ws;
    unsigned* ctl = (unsigned*)(ws + WS_CTL);
    float* out = args.out;
    bf16* W1GU = (bf16*)(ws + WS_W1GU); bf16* W1D = (bf16*)(ws + WS_W1D); bf16* W2GU = (bf16*)(ws + WS_W2GU); bf16* W2D = (bf16*)(ws + WS_W2D);
    bf16* WIN = (bf16*)(ws + WS_WIN); bf16* WUQ = (bf16*)(ws + WS_WUQ); bf16* WUK = (bf16*)(ws + WS_WUK); bf16* WUV = (bf16*)(ws + WS_WUV); bf16* WOUT = (bf16*)(ws + WS_WOUT);
    bf16* XN = (bf16*)(ws + WS_XN); bf16* HID = (bf16*)(ws + WS_HID); bf16* Z = (bf16*)(ws + WS_Z); bf16* QAN = (bf16*)(ws + WS_QAN); bf16* QH = (bf16*)(ws + WS_QH);
    bf16* CALL = (bf16*)(ws + WS_CALL); bf16* KRA = (bf16*)(ws + WS_KR); bf16* KN = (bf16*)(ws + WS_KN); bf16* VT = (bf16*)(ws + WS_VT);
    float* slabs = (float*)(ws + WS_SLAB); bf16* HB = (bf16*)(ws + WS_HB);
    float* rcos = (float*)(ws + WS_TAB); float* rsin = rcos + 8192 * 128; float* mcos = rsin + 8192 * 128; float* msin = mcos + 8192 * 32;

    for (int u = tid; u < (LDS_BYTES - RING_BYTES) / 4; u += NWAVES * 64) ((LAS unsigned*)(lds + RING_BYTES))[u] = 0u;
    __syncthreads();
    volatile LAS unsigned* ARGP = (volatile LAS unsigned*)(lds + MISC_OFF + 256);
    if (tid < 26) { const unsigned long long pv = (unsigned long long)args.in[tid]; ARGP[2 * tid] = (unsigned)pv; ARGP[2 * tid + 1] = (unsigned)(pv >> 32); }
    __syncthreads();
#define ARGIN(k) ((const float*)(((unsigned long long)(unsigned)__builtin_amdgcn_readfirstlane((int)ARGP[2 * (k) + 1]) << 32) | (unsigned long long)(unsigned)__builtin_amdgcn_readfirstlane((int)ARGP[2 * (k)])))
    XcdBarrier bar = xcd_barrier_post(ctl + CW_BAR + args.li * XCD_BAR_WORDS, MISC + 8);
    const int lo = args.ph_lo, hi = args.ph_hi;
#ifndef MK_PHASE_MASK
#define MK_PHASE_MASK 0x7fff
#endif
#define IN(k) ((((MK_PHASE_MASK) >> (k)) & 1) && lo <= (k) && (k) < hi)
#define NEXTP(k) ((k) == 6 ? 8 : (k) + 1)
#define SEAM(k) do { if (IN(k) && IN(NEXTP(k))) xcd_barrier(bar); } while (0)

    constexpr int BGQ_B0 = (DM / 64) * (DIN / 32), BGQ_B1 = BGQ_B0 + 16 * 96, BGQ_B2 = BGQ_B1 + 8 * 128, BGQ_B3 = BGQ_B2 + 64 * 128, BGQ_B4 = BGQ_B3 + 64 * (DFF / 32), BGQ_B5 = BGQ_B4 + 64 * (DFF / 32), BGQ_B6 = BGQ_B5 + (DFF / 64) * 128, BGQ_B7 = BGQ_B6 + (DFF / 64) * 128;
    static_assert(BGQ_B0 % 64 == 0 && BGQ_B1 % 64 == 0 && BGQ_B2 % 64 == 0 && BGQ_B3 % 64 == 0 && BGQ_B4 % 64 == 0 && BGQ_B5 % 64 == 0 && BGQ_B6 % 64 == 0 && BGQ_B7 % 64 == 0, "a chunk of 64 items never straddles two matrices");
#define BG_DRAIN(ctr_, it_lo_, it_hi_) do { \
        for (;;) { \
            if (tid == 0) MISC[0] = __hip_atomic_fetch_add((ctr_), 1u, __ATOMIC_RELAXED, __HIP_MEMORY_SCOPE_AGENT); \
            __syncthreads(); \
            const int ch_ = (int)__builtin_amdgcn_readfirstlane(MISC[0]); \
            __syncthreads(); \
            const int it0 = (it_lo_) + ch_ * 64; if (it0 >= (it_hi_)) break; \
            _Pragma("unroll 1") \
            for (int q = 0; q < 8; q += 4) { const int it = it0 + wave * 8 + q; \
                if (it0 < BGQ_B0) convert_items4(ARGIN(10), DM, DIN, 0, WIN, nullptr, scr, it, lane); \
                else if (it0 < BGQ_B1) convert_items4(ARGIN(13), 1024, 3072, 0, WUQ, nullptr, scr, it - BGQ_B0, lane); \
                else if (it0 < BGQ_B2) convert_items4(ARGIN(18), 512, 4096, 3, WUK, WUV, scr, it - BGQ_B1, lane); \
                else if (it0 < BGQ_B3) convert_items4(ARGIN(20), DM, DM, 0, WOUT, nullptr, scr, it - BGQ_B2, lane); \
                else if (it0 < BGQ_B4) convert_items4(ARGIN(22), DM, DFF, 1, W2GU, nullptr, scr, it - BGQ_B3, lane); \
                else if (it0 < BGQ_B5) convert_items4(ARGIN(23), DM, DFF, 2, W2GU, nullptr, scr, it - BGQ_B4, lane); \
                else if (it0 < BGQ_B6) convert_items4(ARGIN(24), DFF, DM, 0, W2D, nullptr, scr, it - BGQ_B5, lane); \
                else convert_items4(ARGIN(8), DFF, DM, 0, W1D, nullptr, scr, it - BGQ_B6, lane); } \
        } } while (0)

#define P0_MISC(gt, NGT) do { const float* x_p = ARGIN(0); const float* x_s = ARGIN(1); \
        for (int i = gt; i < (ZLD - DIN) * DM / 8; i += NGT) ((GAS v4u*)(WIN + (size_t)DIN * DM))[i] = (v4u){0u, 0u, 0u, 0u}; \
        for (int i = gt; i < 8192 * 128; i += NGT) { float c, s; sincos_tab(i >> 7, i & 127, 128, c, s); rcos[i] = c; rsin[i] = s; } \
        for (int i = gt; i < 8192 * 32; i += NGT) { float c, s; sincos_tab(i >> 5, i & 31, 32, c, s); mcos[i] = c; msin[i] = s; } \
        for (int i = gt; i < 8 * 1024 * 512 / 8; i += NGT) { const int e = i * 8, sb = e / (1024 * 512), rem = e - sb * 1024 * 512, p = rem >> 9, c = rem & 511; \
            const f32x4 a = *(const GAS f32x4*)(ARGIN(3) + e), b = *(const GAS f32x4*)(ARGIN(3) + e + 4); \
            v4u w; w.x = pk2(a.x, a.y); w.y = pk2(a.z, a.w); w.z = pk2(b.x, b.y); w.w = pk2(b.z, b.w); \
            *(GAS v4u*)(CALL + (size_t)(TP + 1088 * sb + p) * 512 + c) = w; } \
        for (int i = gt; i < 8 * 1024 * 64 / 8; i += NGT) { const int e = i * 8, sb = e / (1024 * 64), rem = e - sb * 1024 * 64, p = rem >> 6, c = rem & 63; \
            const f32x4 a = *(const GAS f32x4*)(ARGIN(4) + e), b = *(const GAS f32x4*)(ARGIN(4) + e + 4); \
            v4u w; w.x = pk2(a.x, a.y); w.y = pk2(a.z, a.w); w.z = pk2(b.x, b.y); w.w = pk2(b.z, b.w); \
            *(GAS v4u*)(KRA + (size_t)(TP + 1088 * sb + p) * 64 + c) = w; } \
        {  \
            pg8::SplitTailOrder S; S.init(TT, DM, G, 0, DFF); S.wgm = MK_WGM_DOWN; const int R = S.nwg / G, rem = S.nwg - R * G; \
            for (int e = gt; e < rem * 16384; e += NGT) { const int tl = e >> 14, w = e & 16383, row = w >> 6, c4 = w & 63; pg8::Unit u; S.tile(R * G + tl, u); \
                const int r = u.pm * 256 + row; const float* src = (r < TP ? x_p + (size_t)r * DM : x_s + (size_t)(r - TP) * DM) + u.pn * 256 + 4 * c4; \
                const f32x4 xv = *(const GAS f32x4*)src; v2u hw; hw.x = pk2(xv.x, xv.y); hw.y = pk2(xv.z, xv.w); *(GAS v2u*)(HB + (size_t)r * DM + u.pn * 256 + 4 * c4) = hw; } } \
    } while (0)
    if (IN(0)) {
        const float* x_p = ARGIN(0); const float* x_s = ARGIN(1);
        LAS float* scr = (LAS float*)(lds + wave * 16384);
        convert_weight(ARGIN(6), DM, DFF, 1, W1GU, nullptr, scr, gw, NGW, lane);
        convert_weight(ARGIN(7), DM, DFF, 2, W1GU, nullptr, scr, gw, NGW, lane);
        if (G <= 248) { const int gt = blockIdx.x * (NWAVES * 64) + tid, NGT = G * NWAVES * 64; P0_MISC(gt, NGT); }
        norm_phase<false, true>(x_p, x_s, ARGIN(5), XN, nullptr, gw, NGW, lane, nullptr, nullptr, 0.f);
    }
    SEAM(0);
    if (IN(1)) {
        constexpr int GG = 248;
        const bool bg_only = G > GG && (int)blockIdx.x >= GG;
        if (!bg_only) { pg8::Gemm g{XN, W1GU, TT, 2 * DFF, DM}; pg8::StaticOrder S; S.init(TT, 2 * DFF, G > GG ? GG : G, (int)blockIdx.x, DM); pg8::EpiSwiGLU E{HID, DFF};
            pg8::gemm_phase<pg8::EpiSwiGLU, pg8::StaticOrder, true, true>(lds, g, S, E); }
        LAS float* scr = (LAS float*)(lds + wave * 16384);
        if (bg_only) { const int gt = ((int)blockIdx.x - GG) * (NWAVES * 64) + tid, NGT = (G - GG) * NWAVES * 64; P0_MISC(gt, NGT); }
        BG_DRAIN(ctl + CW_BGQ + 256 + 64 * args.li, BGQ_B6, BGQ_B7);
        BG_DRAIN(ctl + CW_BGQ + 64 * args.li, 0, (G == 256) ? BGQ_B2 : BGQ_B6);
    }
    SEAM(1);
    if (IN(2)) { pg8::Gemm g{HID, W1D, TT, DM, DFF}; pg8::SplitTailOrder S; S.init(TT, DM, G, (int)blockIdx.x, DFF); S.wgm = MK_WGM_DOWN; pg8::EpiResid<false> E{ARGIN(0), ARGIN(1), TP / 256, HB, DM, 0.5f, DFF / 64, slabs};
        pg8::gemm_phase<pg8::EpiResid<false>, pg8::SplitTailOrder, true, true>(lds, g, S, E); }
    SEAM(2);
    if (IN(3)) { LAS unsigned char* tab = lds; build_split_tab(tab, G, DFF, tid, MK_WGM_DOWN);
        norm_phase_h<true>(HB, ARGIN(9), XN, nullptr, gw, NGW, lane, tab, slabs, 0.5f, 8); }
    SEAM(3);
    if (IN(4)) { pg8::Gemm g{XN, WIN, TT, ZLD, DM}; pg8::WinOrder S; S.init(TT, ZLD, G, (int)blockIdx.x, DM); S.r0 = 0; S.r1 = (G == 256) ? 10 : (1 << 20); pg8::EpiZ E{Z, ZLD, rcos, rsin};
        pg8::gemm_phase<pg8::EpiZ, pg8::WinOrder, true, true>(lds, g, S, E); }
    SEAM(4);
    if (IN(5)) {
        const float* gqa = ARGIN(12); const float* gkva = ARGIN(16);
        const f32x4 gq0 = *(const GAS f32x4*)(gqa + 8 * lane), gq1 = *(const GAS f32x4*)(gqa + 8 * lane + 4), gq2 = *(const GAS f32x4*)(gqa + 512 + 8 * lane), gq3 = *(const GAS f32x4*)(gqa + 512 + 8 * lane + 4);
        const f32x4 gk0 = *(const GAS f32x4*)(gkva + 8 * lane), gk1 = *(const GAS f32x4*)(gkva + 8 * lane + 4);
        const float gkr = ARGIN(17)[lane];
        v4u nqa, nqb, nkv; unsigned nkr = 0u; float ncs = 0.f, nsn = 0.f;
#define P5_LOAD(rr) do { const bf16* zr_ = Z + (size_t)(rr) * ZLD + 8192; nqa = *(const GAS v4u*)(zr_ + 8 * lane); nqb = *(const GAS v4u*)(zr_ + 512 + 8 * lane); nkv = *(const GAS v4u*)(zr_ + 1024 + 8 * lane); nkr = (unsigned)zr_[1536 + lane]; \
        const int pp_ = pos_of_row(rr); ncs = mcos[pp_ * 32 + (lane & 31)]; nsn = msin[pp_ * 32 + (lane & 31)]; } while (0)
        if (gw < TT) P5_LOAD(gw);
        for (int r = gw; r < TT; r += NGW) {
            const v4u qa = nqa, qb = nqb, kv = nkv; const float kr = bflo(nkr), c = ncs, sn = nsn;
            if (r + NGW < TT) P5_LOAD(r + NGW);
            float q[16], c8[8];
            q[0] = bflo(qa.x); q[1] = bfhi(qa.x); q[2] = bflo(qa.y); q[3] = bfhi(qa.y); q[4] = bflo(qa.z); q[5] = bfhi(qa.z); q[6] = bflo(qa.w); q[7] = bfhi(qa.w);
            q[8] = bflo(qb.x); q[9] = bfhi(qb.x); q[10] = bflo(qb.y); q[11] = bfhi(qb.y); q[12] = bflo(qb.z); q[13] = bfhi(qb.z); q[14] = bflo(qb.w); q[15] = bfhi(qb.w);
            c8[0] = bflo(kv.x); c8[1] = bfhi(kv.x); c8[2] = bflo(kv.y); c8[3] = bfhi(kv.y); c8[4] = bflo(kv.z); c8[5] = bfhi(kv.z); c8[6] = bflo(kv.w); c8[7] = bfhi(kv.w);
            float sq = 0.f, sc = 0.f;
#pragma unroll
            for (int i = 0; i < 16; ++i) sq += q[i] * q[i];
#pragma unroll
            for (int i = 0; i < 8; ++i) sc += c8[i] * c8[i];
            const float rq = 1.0f / sqrtf(wave_sum(sq) * (1.0f / 1024.0f) + EPSN), rc = 1.0f / sqrtf(wave_sum(sc) * (1.0f / 512.0f) + EPSN), rk = 1.0f / sqrtf(wave_sum(kr * kr) * (1.0f / 64.0f) + EPSN);
            { v4u w;
              w.x = pk2(q[0] * rq * gq0.x, q[1] * rq * gq0.y); w.y = pk2(q[2] * rq * gq0.z, q[3] * rq * gq0.w); w.z = pk2(q[4] * rq * gq1.x, q[5] * rq * gq1.y); w.w = pk2(q[6] * rq * gq1.z, q[7] * rq * gq1.w);
              *(GAS v4u*)(QAN + (size_t)r * 1024 + 8 * lane) = w;
              w.x = pk2(q[8] * rq * gq2.x, q[9] * rq * gq2.y); w.y = pk2(q[10] * rq * gq2.z, q[11] * rq * gq2.w); w.z = pk2(q[12] * rq * gq3.x, q[13] * rq * gq3.y); w.w = pk2(q[14] * rq * gq3.z, q[15] * rq * gq3.w);
              *(GAS v4u*)(QAN + (size_t)r * 1024 + 512 + 8 * lane) = w; }
            const int cr = crow_of_row(r);
            float* ock = r < TP ? out + O_CKP + (size_t)r * 512 : out + O_CKS + (size_t)(r - TP) * 512;
            float* okr = r < TP ? out + O_KRP + (size_t)r * 64 : out + O_KRS + (size_t)(r - TP) * 64;
            { const f32x4 o0 = (f32x4){c8[0] * rc * gk0.x, c8[1] * rc * gk0.y, c8[2] * rc * gk0.z, c8[3] * rc * gk0.w}, o1 = (f32x4){c8[4] * rc * gk1.x, c8[5] * rc * gk1.y, c8[6] * rc * gk1.z, c8[7] * rc * gk1.w};
              __builtin_nontemporal_store(o0, (GAS f32x4*)(ock + 8 * lane)); __builtin_nontemporal_store(o1, (GAS f32x4*)(ock + 8 * lane + 4));
              v4u w; w.x = pk2(o0.x, o0.y); w.y = pk2(o0.z, o0.w); w.z = pk2(o1.x, o1.y); w.w = pk2(o1.z, o1.w);
              *(GAS v4u*)(CALL + (size_t)cr * 512 + 8 * lane) = w; }
            { const float y = kr * rk * gkr; const float yp = __shfl_xor(y, 32);
              const float o = lane < 32 ? y * c - yp * sn : y * c + yp * sn;
              okr[lane] = o; KRA[(size_t)cr * 64 + lane] = (bf16)f2bf(o); }
        }
#undef P5_LOAD
    }
    SEAM(5);
    if (IN(6)) {
        const int c = (int)blockIdx.x; const bool part = (G == 256);
        if (!part || c < 120) { pg8::Gemm g{QAN, WUQ, TT, QLD, 1024}; pg8::StaticOrder S; S.init(TT, QLD, part ? 120 : G, c, 1024); pg8::EpiBf16P E{QH, QLD};
          pg8::gemm_phase<pg8::EpiBf16P, pg8::StaticOrder, true, true>(lds, g, S, E); }
        if (!part || (c >= 120 && c < 181)) { pg8::Gemm g{CALL, WUK, KROWS, KNLD, 512}; pg8::StaticOrder S; S.init(KROWS, KNLD, part ? 61 : G, part ? c - 120 : c, 512); pg8::EpiKNorm E{KN, KNLD, ARGIN(19), (LAS float*)(lds + RING_BYTES + 4096)};
          pg8::gemm_phase<pg8::EpiKNorm, pg8::StaticOrder, true, true>(lds, g, S, E); }
        if (!part || (c >= 181 && c < 242)) { pg8::Gemm g{WUV, CALL, 2048, KROWS, 512}; pg8::StaticOrder S; S.init(2048, KROWS, part ? 61 : G, part ? c - 181 : c, 512); pg8::EpiBf16P E{VT, KROWS};
          pg8::gemm_phase<pg8::EpiBf16P, pg8::StaticOrder, true, true>(lds, g, S, E); }
        if (part && c >= 242) { pg8::Gemm g{XN, WIN, TT, ZLD, DM}; pg8::WinOrder S; S.init(TT, ZLD, 256, c - 242, DM); S.r0 = 10; S.r1 = 11; pg8::EpiZ E{Z, ZLD, rcos, rsin};
          pg8::gemm_phase<pg8::EpiZ, pg8::WinOrder, true, true>(lds, g, S, E); }
    }
    SEAM(6);
    if (IN(8)) {
        constexpr int NQ_RP = 4, NQ_AP = 128, NQ_AS = 16, NQ_RS = 16, NQ = NQ_RP + NQ_AP + NQ_AS + NQ_RS;
        const int myx = (int)(xb_xcc_id() & 7u);
        if (G == 256 && (int)blockIdx.x >= 232) {
            LAS float* scr = (LAS float*)(lds + wave * 16384);
            BG_DRAIN(ctl + CW_BGQ + 128 + 64 * args.li, BGQ_B2, BGQ_B6);
            __syncthreads();
        }
        int qoff = 0;
        for (;;) {
            const int qx = (myx + qoff) & 7;
            if (tid == 0) MISC[0] = __hip_atomic_fetch_add(ctl + CW_QUEUE + 64 * (8 * args.li + qx), 1u, __ATOMIC_RELAXED, __HIP_MEMORY_SCOPE_AGENT);
            __syncthreads();
            const int li_ = (int)__builtin_amdgcn_readfirstlane(MISC[0]);
            __syncthreads();
            if (li_ >= NQ) { if (++qoff == 8) break; continue; }
            int kind, p0, p1, p2;
            bool is_ret;
            if (li_ < NQ_RP) { const int idx = qx * NQ_RP + li_; is_ret = true; kind = 0; p0 = idx >> 4; p1 = (idx >> 1) & 7; p2 = idx & 1; }
            else if (li_ < NQ_RP + NQ_AP + NQ_AS) {
                const int ua = li_ - NQ_RP;
                if (ua >= 112 && ua < 112 + NQ_AS) { const int u = qx * NQ_AS + (ua - 112); is_ret = false; kind = 1; p0 = 0; p1 = u >> 4; p2 = u & 15; }
                else { const int u = ua < 112 ? ua : ua - NQ_AS, bh = 4 * qx + (u & 3); is_ret = false; kind = 0; p0 = 31 - (u >> 2); p1 = bh >> 4; p2 = bh & 15; } }
            else { const int u = qx * NQ_RS + (li_ - NQ_RP - NQ_AP - NQ_AS); is_ret = true; kind = 1; p0 = u >> 4; p1 = (u >> 1) & 7; p2 = u & 1; }
            int tid2 = tid; asm volatile("" : "+v"(tid2));
            if (is_ret) {
#ifndef MK_NO_RET
                float* so = kind == 0 ? out + O_SRP + (size_t)(p0 * 8 + p1) * 65536 : out + O_SRS + (size_t)(p0 * 8 + p1) * 65536;
                ret_unit(lds, kind, p0, p1, p2, Z, XN, ARGIN(2), so, tid2);
#ifdef MK_RET2
                if (kind == 0) { asm volatile("" : "+v"(tid2)); ret_unit(lds, kind, p0, p1, p2, Z, XN, ARGIN(2), so, tid2); }
#endif
#endif
            } else {
#ifndef MK_NO_ATT
                const int qrow0 = kind == 0 ? p1 * SEQ + 256 * p0 : TP + 64 * p1, krow0 = kind == 0 ? p1 * SEQ : TP + 1088 * p1;
                attn_unit(lds, qrow0, kind == 0 ? 8 : 2, krow0, kind == 0 ? 4 * p0 + 4 : 17, kind == 0 ? 4 * p0 : -1, p2, QH, KN, KRA, VT, XN, tid2, ARGIN(14), ARGIN(15), mcos, msin);
#endif
            }
        }
    }
    SEAM(8);
    if (IN(9)) {
#define P9_DPP(x, ctrl) __builtin_bit_cast(float, __builtin_amdgcn_update_dpp(0, __builtin_bit_cast(int, (float)(x)), (ctrl), 0xF, 0xF, false))
#define P9_SUM32(v) do { v += P9_DPP(v, 0xB1); v += P9_DPP(v, 0x4E); v += P9_DPP(v, 0x141); v += P9_DPP(v, 0x140); v += __shfl_xor(v, 16); } while (0)
        v4u pn[4], pg[4];
        f32x4 gg[8];
        { const float* gp = ARGIN(11);
#pragma unroll
          for (int k = 0; k < 4; ++k) { gg[2 * k] = *(const GAS f32x4*)(gp + 512 * k + 8 * lane); gg[2 * k + 1] = *(const GAS f32x4*)(gp + 512 * k + 8 * lane + 4); } }
#define P9_LOAD(rr) do { const bf16* b_ = XN + (size_t)(rr) * DM + 8 * lane; const bf16* g_ = Z + (size_t)(rr) * ZLD + 6144 + 8 * lane; \
            _Pragma("unroll") for (int k = 0; k < 4; ++k) { pn[k] = *(const GAS v4u*)(b_ + 512 * k); pg[k] = __builtin_nontemporal_load((const GAS v4u*)(g_ + 512 * k)); } } while (0)
        if (gw < TT) P9_LOAD(gw);
        for (int r = gw; r < TT; r += NGW) {
            bf16* base = XN + (size_t)r * DM + 8 * lane;
            v4u nv[4], gv[4];
#pragma unroll
            for (int k = 0; k < 4; ++k) { nv[k] = pn[k]; gv[k] = pg[k]; }
            if (r + NGW < TT) P9_LOAD(r + NGW);
#pragma unroll
            for (int k = 0; k < 4; ++k) { float x[8], gt[8];
                x[0] = bflo(nv[k].x); x[1] = bfhi(nv[k].x); x[2] = bflo(nv[k].y); x[3] = bfhi(nv[k].y); x[4] = bflo(nv[k].z); x[5] = bfhi(nv[k].z); x[6] = bflo(nv[k].w); x[7] = bfhi(nv[k].w);
                gt[0] = bflo(gv[k].x); gt[1] = bfhi(gv[k].x); gt[2] = bflo(gv[k].y); gt[3] = bfhi(gv[k].y); gt[4] = bflo(gv[k].z); gt[5] = bfhi(gv[k].z); gt[6] = bflo(gv[k].w); gt[7] = bfhi(gv[k].w);
                float sm = ((x[0] + x[1]) + (x[2] + x[3])) + ((x[4] + x[5]) + (x[6] + x[7]));
                P9_SUM32(sm);
                const float mu = sm * (1.0f / 256.0f); float sv = 0.f;
#pragma unroll
                for (int i = 0; i < 8; ++i) { x[i] -= mu; sv += x[i] * x[i]; }
                P9_SUM32(sv);
                const float rs = 1.0f / sqrtf(sv * (1.0f / 256.0f) + EPSN);
                float o[8];
#pragma unroll
                for (int i = 0; i < 8; ++i) o[i] = x[i] * rs * gg[2 * k + (i >> 2)][i & 3] * pg8::fast_silu(gt[i]);
                v4u w; w.x = pk2(o[0], o[1]); w.y = pk2(o[2], o[3]); w.z = pk2(o[4], o[5]); w.w = pk2(o[6], o[7]); *(GAS v4u*)(base + 512 * k) = w; }
        }
#undef P9_LOAD
#undef P9_SUM32
#undef P9_DPP
    }
    SEAM(9);
    if (IN(10)) { pg8::Gemm g{XN, WOUT, TT, DM, DM}; pg8::SplitTailOrder S; S.init(TT, DM, G, (int)blockIdx.x, DM); pg8::EpiResid<true> E{nullptr, nullptr, 1 << 20, HB, DM, 1.0f, DM / 64, slabs};
        pg8::gemm_phase<pg8::EpiResid<true>, pg8::SplitTailOrder, true, true>(lds, g, S, E); }
    SEAM(10);
    if (IN(11)) { LAS unsigned char* tab = lds; build_split_tab(tab, G, DM, tid, 8);
        norm_phase_h<true>(HB, ARGIN(21), XN, nullptr, gw, NGW, lane, tab, slabs, 1.0f, 8); }
    SEAM(11);
    if (IN(12)) { pg8::Gemm g{XN, W2GU, TT, 2 * DFF, DM}; pg8::StaticOrder S; S.init(TT, 2 * DFF, G, (int)blockIdx.x, DM); pg8::EpiSwiGLU E{HID, DFF};
        pg8::gemm_phase<pg8::EpiSwiGLU, pg8::StaticOrder, true, true>(lds, g, S, E); }
    SEAM(12);
    if (IN(13)) { pg8::Gemm g{HID, W2D, TT, DM, DFF}; pg8::SplitTailOrder S; S.init(TT, DM, G, (int)blockIdx.x, DFF); S.wgm = MK_WGM_DOWN; pg8::EpiResid<true> E{nullptr, nullptr, 1 << 20, HB, DM, 0.5f, DFF / 64, slabs};
        pg8::gemm_phase<pg8::EpiResid<true>, pg8::SplitTailOrder, true, true>(lds, g, S, E); }
    SEAM(13);
    if (IN(14)) { LAS unsigned char* tab = lds; build_split_tab(tab, G, DFF, tid, MK_WGM_DOWN);
        norm_phase_y(HB, ARGIN(25), out, gw, NGW, lane, tab, slabs, 0.5f, 8); }
#ifdef MK_PROBE_SUMS
    if (lo <= 14 && 14 < hi) {
        const int gt = blockIdx.x * (NWAVES * 64) + tid, NGT = G * NWAVES * 64;
        for (size_t i = gt; i < (size_t)TT * DM; i += NGT) if (i >= 65536) out[i] = 0.f;
        for (int r = gw; r < TT + KROWS + 2048; r += NGW) {
            const bf16* src; int n;
            if (r < TT) { src = QH + (size_t)r * QLD; n = QLD; } else if (r < TT + KROWS) { src = KN + (size_t)(r - TT) * KNLD; n = KNLD; } else { src = VT + (size_t)(r - TT - KROWS) * KROWS; n = KROWS; }
            float s = 0.f;
            for (int i = lane; i < n; i += 64) s += bflo((unsigned)src[i]) * (float)(1 + (i & 7));
            s = wave_sum(s);
            if (lane == 0) out[r] = s;
        }
    }
#endif
#ifdef MK_NO_RET
    if (lo <= 14 && 14 < hi) {
#else
    if (!((MK_PHASE_MASK >> 8) & 1) && lo <= 14 && 14 < hi) {
#endif
        const int gt = blockIdx.x * (NWAVES * 64) + tid, NGT = G * NWAVES * 64;
        for (int i = gt; i < 1048576; i += NGT) out[O_SRP + i] = 0.f;
        for (int i = gt; i < 4194304; i += NGT) out[O_SRS + i] = 0.f;
    }
#undef IN
#undef SEAM
}

#ifndef MK_CUT
#define MK_CUT 0
#endif
extern "C" void kernel_launch(void* const* d_in, const int* in_sizes, int n_in, void* d_out, int out_size, void* d_ws, size_t ws_size, hipStream_t stream) {
    static int grid = 0;
    if (grid == 0) {
        if (n_in != 26 || (size_t)out_size != O_END || ws_size < WS_END) { fprintf(stderr, "kernel_launch: unexpected problem (n_in %d, out %d, ws %zu < %zu); nothing launched\n", n_in, out_size, ws_size, (size_t)WS_END); grid = -1; return; }
        int dev = 0, cus = 0, per_cu = 0;
        if (hipGetDevice(&dev) != hipSuccess || hipDeviceGetAttribute(&cus, hipDeviceAttributeMultiprocessorCount, dev) != hipSuccess) { grid = -1; return; }
        if (hipFuncSetAttribute((const void*)mk_fwd, hipFuncAttributeMaxDynamicSharedMemorySize, LDS_BYTES) != hipSuccess) { fprintf(stderr, "kernel_launch: hipFuncSetAttribute failed\n"); grid = -1; return; }
        if (hipOccupancyMaxActiveBlocksPerMultiprocessor(&per_cu, (const void*)mk_fwd, NWAVES * 64, LDS_BYTES) != hipSuccess || per_cu < 1) { fprintf(stderr, "kernel_launch: occupancy query says %d blocks per CU\n", per_cu); }
        (void)hipGetLastError();
        grid = cus;
    }
    if (grid < 0) return;
    (void)hipMemsetAsync((char*)d_ws + WS_CTL, 0, CTL_ZERO_BYTES, stream);
    Args a{};
    for (int i = 0; i < 26; ++i) a.in[i] = (const float*)d_in[i];
    a.out = (float*)d_out; a.ws = (unsigned char*)d_ws; a.li = 0; a.pad1 = 0;
#if MK_CUT
    for (int p = 0; p < N_PHASES; ++p) { a.ph_lo = p; a.ph_hi = p + 1; hipLaunchKernelGGL(mk_fwd, dim3(grid), dim3(NWAVES * 64), LDS_BYTES, stream, a); }
#elif defined(MK_DUP_LO)
    a.ph_lo = 0; a.ph_hi = MK_DUP_HI; a.li = 0;
    hipLaunchKernelGGL(mk_fwd, dim3(grid), dim3(NWAVES * 64), LDS_BYTES, stream, a);
    a.ph_lo = MK_DUP_LO; a.ph_hi = N_PHASES; a.li = 1;
    hipLaunchKernelGGL(mk_fwd, dim3(grid), dim3(NWAVES * 64), LDS_BYTES, stream, a);
#else
    a.ph_lo = 0; a.ph_hi = N_PHASES;
    hipLaunchKernelGGL(mk_fwd, dim3(grid), dim3(NWAVES * 64), LDS_BYTES, stream, a);
#endif
}
```
